# Optimizing an MI355X kernel written in HIP

```python
import jax
import jax.numpy as jnp
from jax import lax
import numpy as np

D_MODEL = 1024
BATCH = 8
SEQ = 2048
DEPTH = 4
DEC_BATCH = 128
DEC_SEQ = 1
PAST_LEN = 16384
PAGE_SIZE = 128

N_MIXERS = 4
N_A = (DEPTH + 3) // 4
N_B = (DEPTH + 2) // 4
N_C = (DEPTH + 1) // 4
N_D = DEPTH // 4
D_FF = 4 * D_MODEL
NORM_EPS = 1e-6

RWKV_HEAD = 64
RWKV_H = D_MODEL // RWKV_HEAD
RWKV_LORA_W = 64
RWKV_LORA_A = 64
RWKV_LORA_G = 160
RWKV_GN_EPS = 64e-5

GLA_H = 4
GLA_DK_TOT = D_MODEL // 2
GLA_DV_TOT = D_MODEL
GLA_DK = GLA_DK_TOT // GLA_H
GLA_DV = GLA_DV_TOT // GLA_H
GLA_LR = 16
GLA_NORMALIZER = 16.0
GLA_CHUNK = 64
GLA_NORM_EPS = 1e-5

CONV_W = 3

POOL_WINDOWS = (2, 4, 8, 16)
POOL_G = D_MODEL // len(POOL_WINDOWS)
POOL_BUF = max(POOL_WINDOWS) - 1

kernel_name = 'hybrid_rwkv7_gla_conv_pool_decoder_step'


def rmsnorm(x, g, eps):
    xf = x.astype(jnp.float32)
    y = xf * lax.rsqrt(jnp.mean(xf * xf, axis=-1, keepdims=True) + eps)
    return (y * g.astype(jnp.float32)).astype(x.dtype)


def sqrelu_mlp(x, w_up, w_down):
    return jnp.square(jax.nn.relu(x @ w_up)) @ w_down


def rwkv7_mix(u, shift_buf, S0, mu, w_rkv, w0, w1, w2, a0, a1, a2, g1, g2, k_k, k_a, r_k, ln_w, ln_b, wo):
    B, L, D = u.shape
    f32 = jnp.float32
    prev = jnp.concatenate([shift_buf[:, None, :].astype(u.dtype), u[:, :-1]], axis=1)
    xm = u[None] + (prev - u)[None] * mu[:, None, None, :].astype(u.dtype)
    xr, xw, xk, xv, xa, xg = xm[0], xm[1], xm[2], xm[3], xm[4], xm[5]
    rkv = jnp.einsum('nbld,nde->nble', jnp.stack([xr, xk, xv]), w_rkv)
    r = rkv[0].astype(f32)
    k = rkv[1].astype(f32)
    v = rkv[2].astype(f32)
    w_log = -jax.nn.softplus(-(w0 + jnp.tanh(xw @ w1) @ w2).astype(f32)) - 0.5
    decay = jnp.exp(-jnp.exp(w_log))
    a = jax.nn.sigmoid((a0 + (xa @ a1) @ a2).astype(f32))
    g = (jax.nn.sigmoid(xg @ g1) @ g2).astype(f32)

    def heads(t):
        return t.reshape(B, L, RWKV_H, RWKV_HEAD)

    kk = heads(k * k_k.astype(f32))
    kk = kk / jnp.maximum(jnp.sqrt(jnp.sum(kk * kk, axis=-1, keepdims=True)), 1e-12)
    k = k * (1.0 + (a - 1.0) * k_a.astype(f32))
    r_h, k_h, v_h, w_h, a_h = heads(r), heads(k), heads(v), heads(decay), heads(a)
    b_h = kk * a_h
    seq = tuple(jnp.moveaxis(t, 1, 0) for t in (r_h, w_h, k_h, v_h, -kk, b_h))

    def step(S, inp):
        r_t, w_t, k_t, v_t, a_t, b_t = inp
        sa = jnp.einsum('bhvk,bhk->bhv', S, a_t)
        S = S * w_t[:, :, None, :] + sa[..., None] * b_t[:, :, None, :] + v_t[..., None] * k_t[:, :, None, :]
        return S, jnp.einsum('bhvk,bhk->bhv', S, r_t)

    S_fin, y = lax.scan(step, S0.astype(f32), seq)
    y = jnp.moveaxis(y, 0, 1)
    mean = jnp.mean(y, axis=-1, keepdims=True)
    var = jnp.mean(jnp.square(y - mean), axis=-1, keepdims=True)
    yn = ((y - mean) * lax.rsqrt(var + RWKV_GN_EPS)).reshape(B, L, D) * ln_w.astype(f32) + ln_b.astype(f32)
    bonus = (jnp.sum(r_h * k_h * r_k.astype(f32), axis=-1, keepdims=True) * v_h).reshape(B, L, D)
    out = ((yn + bonus) * g).astype(u.dtype) @ wo
    return out, S_fin.astype(S0.dtype), u[:, -1]


def gla_chunked(q, k, v, gk, S0):
    B, L, H, DK = q.shape
    DV = v.shape[-1]
    C = min(GLA_CHUNK, L)
    n = -(-L // C)
    pad = n * C - L
    f32 = jnp.float32

    def blocks(t):
        t = jnp.pad(t.astype(f32), ((0, 0), (0, pad), (0, 0), (0, 0)))
        return jnp.moveaxis(t.reshape(B, n, C, H, t.shape[-1]), 1, 0)

    mask = jnp.tril(jnp.ones((C, C), dtype=bool))[None, :, :, None, None]

    def step(S, inp):
        qc, kc, vc, gc = inp
        b = jnp.cumsum(gc, axis=1)
        o_inter = jnp.einsum('bchk,bhkv->bchv', qc * jnp.exp(b), S)
        diff = b[:, :, None] - b[:, None, :]
        dec = jnp.exp(jnp.where(mask, diff, -jnp.inf))
        att = jnp.einsum('btshk,bthk,bshk->bhts', dec, qc, kc)
        o_intra = jnp.einsum('bhts,bshv->bthv', att, vc)
        b_last = b[:, -1]
        S = jnp.exp(b_last)[..., None] * S + jnp.einsum('bshk,bshv->bhkv', kc * jnp.exp(b_last[:, None] - b), vc)
        return S, o_inter + o_intra

    S_fin, o = lax.scan(step, S0.astype(f32), (blocks(q), blocks(k), blocks(v), blocks(gk)))
    o = jnp.moveaxis(o, 0, 1).reshape(B, n * C, H, DV)[:, :L]
    return o, S_fin


def gla_mix(u, S0, w_in, w_gk2, b_gk, norm_w, wo):
    B, L, D = u.shape
    z = u @ w_in
    q, k, v, g, gl = jnp.split(z, [GLA_DK_TOT, 2 * GLA_DK_TOT, 2 * GLA_DK_TOT + GLA_DV_TOT, 2 * GLA_DK_TOT + 2 * GLA_DV_TOT], axis=-1)
    gk = jax.nn.log_sigmoid((gl @ w_gk2 + b_gk).astype(jnp.float32)) / GLA_NORMALIZER
    q = q.reshape(B, L, GLA_H, GLA_DK) * (GLA_DK ** -0.5)
    k = k.reshape(B, L, GLA_H, GLA_DK)
    v = v.reshape(B, L, GLA_H, GLA_DV)
    gk = gk.reshape(B, L, GLA_H, GLA_DK)
    o, S_fin = gla_chunked(q, k, v, gk, S0)
    o = rmsnorm(o, norm_w, GLA_NORM_EPS) * jax.nn.silu(g.reshape(B, L, GLA_H, GLA_DV).astype(jnp.float32))
    out = o.reshape(B, L, GLA_DV_TOT).astype(u.dtype) @ wo
    return out, S_fin.astype(S0.dtype)


def conv_mix(u, buf, w_in, w_conv, wo):
    L = u.shape[1]
    gB, gC, h = jnp.split(u @ w_in, 3, axis=-1)
    zc = jnp.concatenate([buf.astype(u.dtype), gC * h], axis=1)
    conv = sum(w_conv[j] * zc[:, j:j + L] for j in range(CONV_W))
    out = (gB * conv) @ wo
    return out, zc[:, -(CONV_W - 1):]


def pool_mix(u, buf, pos0, pool_w, scale):
    B, L, D = u.shape
    zc = jnp.concatenate([buf.astype(u.dtype), u], axis=1)
    zf = zc.astype(jnp.float32)
    cs = jnp.concatenate([jnp.zeros((B, 1, D), jnp.float32), jnp.cumsum(zf, axis=1)], axis=1)
    pos = pos0 + jnp.arange(L)
    uf = u.astype(jnp.float32)
    ys = []
    for gi, w in enumerate(POOL_WINDOWS):
        sl = slice(gi * POOL_G, (gi + 1) * POOL_G)
        s = cs[:, POOL_BUF + 1:POOL_BUF + 1 + L, sl] - cs[:, POOL_BUF + 1 - w:POOL_BUF + 1 - w + L, sl]
        cnt = jnp.minimum(w, pos + 1).astype(jnp.float32)
        d = s / cnt[None, :, None] - uf[:, :, sl]
        ys.append(d.astype(u.dtype) @ pool_w[gi])
    out = jnp.concatenate(ys, axis=-1) * scale
    return out, zc[:, -POOL_BUF:]


def setup_inputs(seed: int = 0) -> dict:
    key = jax.random.key(seed)
    ks = iter(jax.random.split(key, 64))
    D = D_MODEL

    def nrm(shape, scale):
        return scale * jax.random.normal(next(ks), shape, jnp.float32)

    def uni(shape, lo, hi):
        return jax.random.uniform(next(ks), shape, jnp.float32, lo, hi)

    inp = {}
    inp['x_prompt'] = nrm((BATCH, SEQ, D), 1.0)
    inp['x_sample'] = nrm((DEC_BATCH, DEC_SEQ, D), 1.0)
    inp['state_rwkv_wkv'] = nrm((N_A, DEC_BATCH, RWKV_H, RWKV_HEAD, RWKV_HEAD), 0.3)
    inp['state_rwkv_shift'] = nrm((N_A, DEC_BATCH, D), 1.0)
    inp['state_gla'] = nrm((N_B, DEC_BATCH, GLA_H, GLA_DK, GLA_DV), 0.3)
    inp['state_conv'] = nrm((N_C, DEC_BATCH, CONV_W - 1, D), 1.0)
    inp['state_pool'] = nrm((N_D, DEC_BATCH, POOL_BUF, D), 1.0)
    inp['norm_mix'] = 1.0 + nrm((DEPTH, D), 0.05)
    inp['norm_ffn'] = 1.0 + nrm((DEPTH, D), 0.05)
    inp['norm_final'] = 1.0 + nrm((D,), 0.05)
    inp['ffn_up'] = nrm((DEPTH, D, D_FF), D ** -0.5)
    inp['ffn_down'] = nrm((DEPTH, D_FF, D), 0.5 * D_FF ** -0.5)
    inp['rwkv_mu'] = uni((N_A, 6, D), 0.0, 1.0)
    inp['rwkv_w_rkv'] = nrm((N_A, 3, D, D), D ** -0.5)
    inp['rwkv_w0'] = uni((N_A, D), -6.0, 1.0)
    inp['rwkv_w1'] = nrm((N_A, D, RWKV_LORA_W), D ** -0.5)
    inp['rwkv_w2'] = nrm((N_A, RWKV_LORA_W, D), 0.1 * RWKV_LORA_W ** -0.5)
    inp['rwkv_a0'] = nrm((N_A, D), 0.1)
    inp['rwkv_a1'] = nrm((N_A, D, RWKV_LORA_A), D ** -0.5)
    inp['rwkv_a2'] = nrm((N_A, RWKV_LORA_A, D), 0.1 * RWKV_LORA_A ** -0.5)
    inp['rwkv_g1'] = nrm((N_A, D, RWKV_LORA_G), D ** -0.5)
    inp['rwkv_g2'] = nrm((N_A, RWKV_LORA_G, D), RWKV_LORA_G ** -0.5)
    inp['rwkv_k_k'] = 0.85 + nrm((N_A, D), 0.05)
    inp['rwkv_k_a'] = 1.0 + nrm((N_A, D), 0.05)
    inp['rwkv_r_k'] = nrm((N_A, RWKV_H, RWKV_HEAD), 0.1)
    inp['rwkv_ln_w'] = 1.0 + nrm((N_A, D), 0.05)
    inp['rwkv_ln_b'] = nrm((N_A, D), 0.02)
    inp['rwkv_wo'] = nrm((N_A, D, D), 0.5 * D ** -0.5)
    inp['gla_w_in'] = nrm((N_B, D, 2 * GLA_DK_TOT + 2 * GLA_DV_TOT + GLA_LR), D ** -0.5)
    inp['gla_w_gk2'] = nrm((N_B, GLA_LR, GLA_DK_TOT), GLA_LR ** -0.5)
    inp['gla_b_gk'] = nrm((N_B, GLA_DK_TOT), 0.1)
    inp['gla_norm'] = 1.0 + nrm((N_B, GLA_DV), 0.05)
    inp['gla_wo'] = nrm((N_B, GLA_DV_TOT, D), 0.5 * GLA_DV_TOT ** -0.5)
    inp['conv_w_in'] = nrm((N_C, D, 3 * D), D ** -0.5)
    inp['conv_w'] = nrm((N_C, CONV_W, D), 0.5)
    inp['conv_wo'] = nrm((N_C, D, D), 0.5 * D ** -0.5)
    inp['pool_w'] = nrm((N_D, len(POOL_WINDOWS), POOL_G, POOL_G), POOL_G ** -0.5)
    inp['pool_scale'] = uni((N_D, D), 0.5, 1.5)
    return inp


def reference(x_prompt, x_sample, state_rwkv_wkv, state_rwkv_shift, state_gla, state_conv, state_pool,
              norm_mix, norm_ffn, norm_final, ffn_up, ffn_down,
              rwkv_mu, rwkv_w_rkv, rwkv_w0, rwkv_w1, rwkv_w2, rwkv_a0, rwkv_a1, rwkv_a2, rwkv_g1, rwkv_g2,
              rwkv_k_k, rwkv_k_a, rwkv_r_k, rwkv_ln_w, rwkv_ln_b, rwkv_wo,
              gla_w_in, gla_w_gk2, gla_b_gk, gla_norm, gla_wo,
              conv_w_in, conv_w, conv_wo,
              pool_w, pool_scale):

    def trunk(h, st_wkv, st_shift, st_gla, st_conv, st_pool, pos0):
        n_wkv, n_shift, n_gla, n_conv, n_pool = [], [], [], [], []
        for i in range(DEPTH):
            j = i // N_MIXERS
            kind = i % N_MIXERS
            u = rmsnorm(h, norm_mix[i], NORM_EPS)
            if kind == 0:
                out, s_new, sh_new = rwkv7_mix(u, st_shift[j], st_wkv[j], rwkv_mu[j], rwkv_w_rkv[j], rwkv_w0[j],
                                               rwkv_w1[j], rwkv_w2[j], rwkv_a0[j], rwkv_a1[j], rwkv_a2[j],
                                               rwkv_g1[j], rwkv_g2[j], rwkv_k_k[j], rwkv_k_a[j], rwkv_r_k[j],
                                               rwkv_ln_w[j], rwkv_ln_b[j], rwkv_wo[j])
                n_wkv.append(s_new)
                n_shift.append(sh_new.astype(st_shift.dtype))
            elif kind == 1:
                out, s_new = gla_mix(u, st_gla[j], gla_w_in[j], gla_w_gk2[j], gla_b_gk[j], gla_norm[j], gla_wo[j])
                n_gla.append(s_new)
            elif kind == 2:
                out, c_new = conv_mix(u, st_conv[j], conv_w_in[j], conv_w[j], conv_wo[j])
                n_conv.append(c_new.astype(st_conv.dtype))
            else:
                out, p_new = pool_mix(u, st_pool[j], pos0, pool_w[j], pool_scale[j])
                n_pool.append(p_new.astype(st_pool.dtype))
            h = h + out.astype(h.dtype)
            h = h + sqrelu_mlp(rmsnorm(h, norm_ffn[i], NORM_EPS), ffn_up[i], ffn_down[i]).astype(h.dtype)
        y = rmsnorm(h, norm_final, NORM_EPS)
        return y, jnp.stack(n_wkv), jnp.stack(n_shift), jnp.stack(n_gla), jnp.stack(n_conv), jnp.stack(n_pool)

    dt = x_prompt.dtype
    y_p, wkv_p, sh_p, gla_p, conv_p, pool_p = trunk(
        x_prompt,
        jnp.zeros((N_A, BATCH, RWKV_H, RWKV_HEAD, RWKV_HEAD), dt),
        jnp.zeros((N_A, BATCH, D_MODEL), dt),
        jnp.zeros((N_B, BATCH, GLA_H, GLA_DK, GLA_DV), dt),
        jnp.zeros((N_C, BATCH, CONV_W - 1, D_MODEL), dt),
        jnp.zeros((N_D, BATCH, POOL_BUF, D_MODEL), dt),
        0)
    y_s, wkv_s, sh_s, gla_s, conv_s, pool_s = trunk(
        x_sample, state_rwkv_wkv, state_rwkv_shift, state_gla, state_conv, state_pool, PAST_LEN)
    return (y_p, y_s, wkv_p, wkv_s, sh_p, sh_s, gla_p, gla_s, conv_p, conv_s, pool_p, pool_s)
```

```cpp
#include <hip/hip_runtime.h>
#include <hip/hip_cooperative_groups.h>
#include <cstdio>
#include <cstdint>
namespace cg = cooperative_groups;

#define LAS __attribute__((address_space(3)))
typedef unsigned short bf16_t;
typedef _Float16 h16;
typedef short bf16x8 __attribute__((ext_vector_type(8)));
typedef float f32x4 __attribute__((ext_vector_type(4)));
typedef float f32x2 __attribute__((ext_vector_type(2)));
typedef unsigned u32x4 __attribute__((ext_vector_type(4)));
typedef unsigned u32x2 __attribute__((ext_vector_type(2)));
typedef _Float16 h16x2 __attribute__((ext_vector_type(2)));
typedef _Float16 h16x4 __attribute__((ext_vector_type(4)));
typedef _Float16 h16x8 __attribute__((ext_vector_type(8)));

constexpr int D = 1024, NPROMPT = 16384, SEQ = 2048, NB = 8, NSB = 128, MREAL = 16512, MP = 16640, DFF = 4096;
constexpr size_t O_Y = 0, O_WKVP = 16908288, O_WKVS = 17432576, O_SHP = 25821184, O_SHS = 25829376, O_GLAP = 25960448, O_GLAS = 27009024,
                 O_CONVP = 43786240, O_CONVS = 43802624, O_POOLP = 44064768, O_POOLS = 44187648;
constexpr size_t W_MIX1 = 0, W_MIX2 = 15728640, W_WO = 17301504, W_UP = 19398656, W_DOWN = 27787264, W_END = 36175872;
constexpr size_t R_W = 0, R_XN = 36700160, R_BIG = R_XN + (size_t)MP * 1024 * 2;
constexpr size_t B_WAG = 0, B_U2 = 0, B_RKV = (size_t)MP * 3072 * 2, B_LH = B_RKV + (size_t)MP * 3072 * 2, B_Y = B_LH + (size_t)MP * 768 * 2, B_END0 = B_Y + (size_t)MP * 1024 * 2;
constexpr size_t B_Z = 0, B_GL = (size_t)MP * 3072 * 2, B_O = B_GL + (size_t)MP * 16 * 4;
constexpr size_t WS_BAR = R_BIG + B_END0;
constexpr size_t WS_NEED = WS_BAR + 16384;
constexpr int LDS_TAB = 155648, LDS_BYTES = 155648 + 512;

struct Args { const float* in[38]; float* out; unsigned char* ws; };
struct Params {
    LAS unsigned long long* tab; float* out; unsigned char* ws;
    __device__ __forceinline__ const float* in(int i) const { const unsigned long long v = tab[i];
        const unsigned lo = __builtin_amdgcn_readfirstlane((unsigned)v), hi = __builtin_amdgcn_readfirstlane((unsigned)(v >> 32));
        return (const float*)(const __attribute__((address_space(1))) float*)(((unsigned long long)hi << 32) | lo); }
};

__device__ __forceinline__ unsigned f2bf(float f) { unsigned u = __builtin_bit_cast(unsigned, f); return (u + 0x7fffu + ((u >> 16) & 1u)) >> 16; }
__device__ __forceinline__ unsigned pk2(float lo, float hi) { return f2bf(lo) | (f2bf(hi) << 16); }
__device__ __forceinline__ u32x2 pk4(f32x4 v) { u32x2 r; r.x = pk2(v[0], v[1]); r.y = pk2(v[2], v[3]); return r; }
__device__ __forceinline__ h16x4 h4(f32x4 v) { h16x4 r; r[0] = (h16)v[0]; r[1] = (h16)v[1]; r[2] = (h16)v[2]; r[3] = (h16)v[3]; return r; }
__device__ __forceinline__ f32x4 f4(h16x4 v) { f32x4 r; r[0] = (float)v[0]; r[1] = (float)v[1]; r[2] = (float)v[2]; r[3] = (float)v[3]; return r; }
template <int CTRL> __device__ __forceinline__ float dppmov(float v) { return __builtin_bit_cast(float, __builtin_amdgcn_update_dpp(0, __builtin_bit_cast(int, v), CTRL, 0xF, 0xF, true)); }
__device__ __forceinline__ float reduce16(float v) {
    v += dppmov<0xB1>(v);
    v += dppmov<0x4E>(v);
    v += dppmov<0x141>(v);
    v += dppmov<0x140>(v);
    return v;
}
__device__ __forceinline__ float wave_sum(float v) {
    v = reduce16(v);
    const int iv = __builtin_bit_cast(int, v);
    const float r0 = __builtin_bit_cast(float, __builtin_amdgcn_readlane(iv, 0)), r1 = __builtin_bit_cast(float, __builtin_amdgcn_readlane(iv, 16));
    const float r2 = __builtin_bit_cast(float, __builtin_amdgcn_readlane(iv, 32)), r3 = __builtin_bit_cast(float, __builtin_amdgcn_readlane(iv, 48));
    return (r0 + r1) + (r2 + r3);
}
__device__ __forceinline__ float fexp(float x) { return __builtin_amdgcn_exp2f(x * 1.4426950408889634f); }
__device__ __forceinline__ float flog(float x) { return __builtin_amdgcn_logf(x) * 0.6931471805599453f; }
__device__ __forceinline__ float sigmoidf_(float x) { return __builtin_amdgcn_rcpf(1.0f + fexp(-x)); }
__device__ __forceinline__ float softplusf_(float x) { return fmaxf(x, 0.f) + flog(1.0f + fexp(-fabsf(x))); }
__device__ __forceinline__ float tanhf_(float x) { return 1.0f - 2.0f * __builtin_amdgcn_rcpf(1.0f + fexp(2.0f * x)); }
#define LDS_WAIT() asm volatile("s_waitcnt lgkmcnt(0)" ::: "memory")
#define LDS_BARRIER() do { asm volatile("s_waitcnt lgkmcnt(0)" ::: "memory"); __builtin_amdgcn_s_barrier(); asm volatile("" ::: "memory"); } while (0)

namespace pg8 {
constexpr int BM = 256, BK = 64, HALF = 128, HTB = HALF * BK * 2, STAGE_BYTES = 8 * HTB, NXCD = 8, WGM = 8;
__host__ __device__ __forceinline__ int lds_byte(int r, int c) { const int st = (r >> 4) * 2 + (c >> 5), rr = r & 15, cc = c & 31, ob = rr * 64 + cc * 2; return st * 1024 + (ob ^ (((ob >> 9) & 1) << 5)); }
__host__ __device__ __forceinline__ void stage_rc(int b, int& R, int& C) { const int st = b / 1024, sb = b % 1024, swz = sb ^ (((sb >> 9) & 1) << 5); R = (st >> 1) * 16 + swz / 64; C = (st & 1) * 32 + (swz % 64) / 2; }
__host__ __device__ __forceinline__ int perm32(int rho) { const int n = rho >> 4, i = rho & 15; return 8 * (i >> 2) + 4 * n + (i & 3); }

__device__ __forceinline__ const char* sgpr_ptr(const char* p) { const unsigned long long v = (unsigned long long)p;
    const unsigned lo = __builtin_amdgcn_readfirstlane((unsigned)v), hi = __builtin_amdgcn_readfirstlane((unsigned)(v >> 32));
    return (const char*)(const __attribute__((address_space(1))) char*)(((unsigned long long)hi << 32) | lo); }
struct Unit { int pm, pn; };
struct Gemm { const bf16_t* A; const bf16_t* Bt; int lda, ldb, K, grp_shift; unsigned a_grp_bytes; };
__device__ __forceinline__ const char* unit_a(const Gemm& g, const Unit& u) { return (const char*)g.A + (size_t)(u.pn >> g.grp_shift) * g.a_grp_bytes + (size_t)u.pm * (size_t)(BM * 2) * (size_t)g.lda; }
__device__ __forceinline__ const char* unit_b(const Gemm& g, const Unit& u) { return (const char*)g.Bt + (size_t)u.pn * (size_t)(BM * 2) * (size_t)g.ldb; }

struct StaticOrder {
    int nM, nN, nwg, G, c;
    __device__ void init(int nM_, int nN_, int G_, int c_) { nM = nM_; nN = nN_; nwg = nM * nN; G = G_; c = c_; }
    __device__ bool next(int i, Unit& u) const {
        const long L = (long)i * G + c; if (L >= nwg) return false;
        int wgid = (int)L; { const int q = nwg / NXCD, r = nwg % NXCD, xcd = wgid % NXCD, off = wgid / NXCD; wgid = (xcd < r ? xcd * (q + 1) : r * (q + 1) + (xcd - r) * q) + off; }
        const int nig = WGM * nN, gid = wgid / nig, fm = gid * WGM, gsz = (nM - fm) < WGM ? (nM - fm) : WGM;
        u.pm = __builtin_amdgcn_readfirstlane(fm + ((wgid % nig) % gsz)); u.pn = __builtin_amdgcn_readfirstlane((wgid % nig) / gsz); return true;
    }
};

template <class Epi>
__device__ __forceinline__ void gemm_phase(const int tid, LAS unsigned char* lds, const Gemm g, const StaticOrder& S, const Epi& E) {
    const int wid = __builtin_amdgcn_readfirstlane(tid >> 6), lane = tid & 63, wr = wid >> 2, wc = wid & 3, fr = lane & 15, fq = lane >> 4;
    const int K = g.K, nt = K / BK;
    unsigned voffA[2], voffB[2];
#pragma unroll
    for (int i = 0; i < 2; ++i) { int R, C; stage_rc(tid * 16 + i * 8192, R, C); const int Rb = Epi::PERM ? ((R & ~31) + perm32(R & 31)) : R;
        voffA[i] = (unsigned)(R * g.lda + C) * 2u; voffB[i] = (unsigned)(Rb * g.ldb + C) * 2u; }
    const size_t kstep = (size_t)(BK * 2);
    const size_t hstepA = (size_t)HALF * g.lda * 2, hstepB = (size_t)HALF * g.ldb * 2;
    const unsigned ldsw = (unsigned)wid * 1024u;
    const int aoff = lds_byte(wr * 64 + fr, fq * 8), boff = lds_byte(wc * 32 + fr, fq * 8);
#define PG8_SA(b, h) (((b) * 2 + (h)) * HTB)
#define PG8_SB(b, h) ((4 + (b) * 2 + (h)) * HTB)
#define PG8_STAGE(bufoff, gbase, voff) do { const char* gb_ = sgpr_ptr(gbase); _Pragma("unroll") for (int _i = 0; _i < 2; ++_i) \
        __builtin_amdgcn_global_load_lds((const unsigned*)(gb_ + (voff)[_i]), (LAS unsigned*)(lds + (bufoff) + ldsw + _i * 8192), 16, 0, 0); } while (0)
#define PG8_LDA(dst, b, h) do { _Pragma("unroll") for (int m = 0; m < 4; ++m) _Pragma("unroll") for (int k = 0; k < 2; ++k) dst[m][k] = *(const LAS bf16x8*)(lds + PG8_SA(b, h) + aoff + m * 2048 + k * 1024); } while (0)
#define PG8_LDB(dst, b, h) do { _Pragma("unroll") for (int n = 0; n < 2; ++n) _Pragma("unroll") for (int k = 0; k < 2; ++k) dst[n][k] = *(const LAS bf16x8*)(lds + PG8_SB(b, h) + boff + n * 2048 + k * 1024); } while (0)
#define PG8_MMA(ai, bj, At, Bt) do { __builtin_amdgcn_s_setprio(1); _Pragma("unroll") for (int m = 0; m < 4; ++m) _Pragma("unroll") for (int n = 0; n < 2; ++n) _Pragma("unroll") for (int k = 0; k < 2; ++k) \
        acc[ai][bj][m][n] = __builtin_amdgcn_mfma_f32_16x16x32_bf16(Bt[n][k], At[m][k], acc[ai][bj][m][n], 0, 0, 0); __builtin_amdgcn_s_setprio(0); } while (0)
#define PG8_WAIT_V(n) asm volatile("s_waitcnt vmcnt(" #n ")" ::: "memory")
#define PG8_WAIT_L(n) asm volatile("s_waitcnt lgkmcnt(" #n ")" ::: "memory")
#define PG8_BAR __builtin_amdgcn_s_barrier()
#define PG8_SCHED __builtin_amdgcn_sched_barrier(0)
    Unit cur, nxt; int ui = 0;
    if (!S.next(0, cur)) return;
    f32x4 acc[2][2][4][2];
    if constexpr (Epi::INIT) E.init(acc, cur, wr, wc, fr, fq);
    else {
#pragma unroll
    for (int a = 0; a < 2; ++a)
#pragma unroll
        for (int b = 0; b < 2; ++b)
#pragma unroll
            for (int m = 0; m < 4; ++m)
#pragma unroll
                for (int n = 0; n < 2; ++n) acc[a][b][m][n] = (f32x4){0.f, 0.f, 0.f, 0.f};
    }
    bf16x8 At[4][2], B0[2][2], B1[2][2];
    const char* cA = unit_a(g, cur); const char* cB = unit_b(g, cur);
    PG8_STAGE(PG8_SB(0, 0), cB, voffB); PG8_STAGE(PG8_SB(0, 1), cB + hstepB, voffB); PG8_STAGE(PG8_SA(0, 0), cA, voffA); PG8_STAGE(PG8_SA(0, 1), cA + hstepA, voffA);
    if (wr == 1) PG8_BAR;
    PG8_WAIT_V(2); PG8_BAR;
    PG8_STAGE(PG8_SB(1, 0), cB + kstep, voffB); PG8_STAGE(PG8_SA(1, 0), cA + kstep, voffA); PG8_STAGE(PG8_SB(1, 1), cB + hstepB + kstep, voffB);
    PG8_WAIT_V(6); PG8_BAR;
    for (;;) {
        const bool has_next = S.next(ui + 1, nxt);
        const char* nA = has_next ? unit_a(g, nxt) : cA; const char* nB = has_next ? unit_b(g, nxt) : cB;
        for (int t = 0; t < nt; t += 2) {
            const bool last = (t == nt - 2);
            const char* a1 = cA + (size_t)(t + 1) * kstep;
            const char* a2 = last ? nA : cA + (size_t)(t + 2) * kstep; const char* b2 = last ? nB : cB + (size_t)(t + 2) * kstep;
            const char* a3 = a2 + kstep; const char* b3 = b2 + kstep;
            PG8_LDB(B0, 0, 0); PG8_LDB(B1, 0, 1); PG8_SCHED; PG8_LDA(At, 0, 0); PG8_STAGE(PG8_SA(1, 1), a1 + hstepA, voffA);
            PG8_WAIT_V(8); PG8_WAIT_L(0); PG8_BAR; PG8_MMA(0, 0, At, B0); PG8_MMA(0, 1, At, B1); PG8_BAR; PG8_SCHED;
            PG8_LDA(At, 0, 1); PG8_STAGE(PG8_SB(0, 0), b2, voffB); PG8_STAGE(PG8_SB(0, 1), b2 + hstepB, voffB); PG8_STAGE(PG8_SA(0, 0), a2, voffA);
            PG8_WAIT_V(8); PG8_WAIT_L(0); PG8_BAR; PG8_MMA(1, 0, At, B0); PG8_MMA(1, 1, At, B1); PG8_BAR; PG8_SCHED;
            PG8_LDB(B0, 1, 0); PG8_LDB(B1, 1, 1); PG8_SCHED; PG8_LDA(At, 1, 0); PG8_STAGE(PG8_SA(0, 1), a2 + hstepA, voffA);
            PG8_WAIT_V(8); PG8_WAIT_L(0); PG8_BAR; PG8_MMA(0, 0, At, B0); PG8_MMA(0, 1, At, B1); PG8_BAR; PG8_SCHED;
            PG8_LDA(At, 1, 1); PG8_STAGE(PG8_SB(1, 0), b3, voffB); PG8_STAGE(PG8_SB(1, 1), b3 + hstepB, voffB); PG8_STAGE(PG8_SA(1, 0), a3, voffA);
            PG8_WAIT_V(8); PG8_WAIT_L(0); PG8_BAR; PG8_MMA(1, 0, At, B0); PG8_MMA(1, 1, At, B1); PG8_BAR; PG8_SCHED;
        }
        if (wr == 0) PG8_BAR;
        E(acc, cur, wr, wc, fr, fq);
        if (!has_next) break;
        if constexpr (Epi::INIT) E.init(acc, nxt, wr, wc, fr, fq);
        else {
#pragma unroll
        for (int a = 0; a < 2; ++a)
#pragma unroll
            for (int b = 0; b < 2; ++b)
#pragma unroll
                for (int m = 0; m < 4; ++m)
#pragma unroll
                    for (int n = 0; n < 2; ++n) acc[a][b][m][n] = (f32x4){0.f, 0.f, 0.f, 0.f};
        }
        cur = nxt; cA = nA; cB = nB; ++ui;
        if (wr == 1) PG8_BAR;
    }
    PG8_WAIT_V(0);
    PG8_BAR;
#undef PG8_SA
#undef PG8_SB
#undef PG8_STAGE
#undef PG8_LDA
#undef PG8_LDB
#undef PG8_MMA
#undef PG8_WAIT_V
#undef PG8_WAIT_L
#undef PG8_BAR
#undef PG8_SCHED
}

enum { EP_RKV = 0, EP_LORA2 = 1, EP_RES = 2, EP_UP = 3, EP_Z = 4, EP_RESI = 5 };
template <int MODE> struct Epi {
    static constexpr bool PERM = (MODE != EP_RES && MODE != EP_RESI), INIT = (MODE == EP_RESI);
    void* o0; void* o1; const float* p0; const float* p1;
    template <bool ATOMIC> __device__ __forceinline__ void put(int row, int col, f32x4 v) const {
        const int pn = col >> 8;
        if constexpr (MODE == EP_RKV) {
            if (pn < 12) { *(h16x4*)((h16*)o0 + (size_t)row * 3072 + col) = h4(v); }
            else {
                if (pn == 12) { v[0] = tanhf_(v[0]); v[1] = tanhf_(v[1]); v[2] = tanhf_(v[2]); v[3] = tanhf_(v[3]); }
                else if (pn == 14) { v[0] = sigmoidf_(v[0]); v[1] = sigmoidf_(v[1]); v[2] = sigmoidf_(v[2]); v[3] = sigmoidf_(v[3]); }
                *(u32x2*)((bf16_t*)o1 + (size_t)row * 768 + (col - 3072)) = pk4(v);
            }
        } else if constexpr (MODE == EP_LORA2) {
            const int grp = pn >> 2, c1 = col & 1023;
            if (grp == 0) { const f32x4 b = *(const f32x4*)(p0 + c1);
#pragma unroll
                for (int j = 0; j < 4; ++j) { const float x = b[j] + v[j]; const float wl = -softplusf_(-x) - 0.5f; v[j] = -fexp(wl); } }
            else if (grp == 1) { const f32x4 b = *(const f32x4*)(p1 + c1);
#pragma unroll
                for (int j = 0; j < 4; ++j) v[j] = sigmoidf_(b[j] + v[j]); }
            *(h16x4*)((h16*)o0 + (size_t)row * 3072 + col) = h4(v);
        } else if constexpr (MODE == EP_RES || MODE == EP_RESI) {
            float* hp = (float*)o0 + (size_t)row * 1024 + col;
            if constexpr (MODE == EP_RES) { if (p0) v = v * *(const f32x4*)(p0 + col); }
            if constexpr (ATOMIC) {
#pragma unroll
                for (int j = 0; j < 4; ++j) (void)__hip_atomic_fetch_add(hp + j, v[j], __ATOMIC_RELAXED, __HIP_MEMORY_SCOPE_AGENT);
            } else *(f32x4*)hp = *(const f32x4*)hp + v;
        } else if constexpr (MODE == EP_UP) {
#pragma unroll
            for (int j = 0; j < 4; ++j) { const float r = fmaxf(v[j], 0.f); v[j] = r * r; }
            *(u32x2*)((bf16_t*)o0 + (size_t)row * 4096 + col) = pk4(v);
        } else {
            if (pn < 12) { *(h16x4*)((h16*)o0 + (size_t)row * 3072 + col) = h4(v); }
            else { const int c = col - 3072; if (c < 16) *(f32x4*)((float*)o1 + (size_t)row * 16 + c) = v; }
        }
    }
    __device__ __forceinline__ void init(f32x4 (&acc)[2][2][4][2], const Unit& u, int wr, int wc, int fr, int fq) const {
        const int rowb = u.pm * BM + wr * 64 + fr, colb = u.pn * BM + wc * 32 + 4 * fq;
#pragma unroll
        for (int ai = 0; ai < 2; ++ai)
#pragma unroll
            for (int m = 0; m < 4; ++m) {
                const float* hrow = (p0 ? p0 : (const float*)o0) + (size_t)(rowb + ai * HALF + m * 16) * 1024 + colb;
#pragma unroll
                for (int bj = 0; bj < 2; ++bj)
#pragma unroll
                    for (int n = 0; n < 2; ++n) acc[ai][bj][m][n] = *(const f32x4*)(hrow + bj * HALF + 16 * n);
            }
    }
    __device__ __forceinline__ void operator()(const f32x4 (&acc)[2][2][4][2], const Unit& u, int wr, int wc, int fr, int fq) const {
        { unsigned ones_ = ~0u; asm volatile("" : "+s"(ones_));
          const int l_ = (int)__builtin_amdgcn_mbcnt_hi(ones_, __builtin_amdgcn_mbcnt_lo(ones_, 0u)); fr = l_ & 15; fq = l_ >> 4; }
        const int rowb = u.pm * BM + wr * 64 + fr;
        const int colb = u.pn * BM + wc * 32 + (PERM ? 8 * fq : 4 * fq);
        if constexpr (MODE == EP_RESI) {
#pragma unroll
            for (int ai = 0; ai < 2; ++ai)
#pragma unroll
                for (int m = 0; m < 4; ++m) {
                    float* hrow = (float*)o0 + (size_t)(rowb + ai * HALF + m * 16) * 1024 + colb;
#pragma unroll
                    for (int bj = 0; bj < 2; ++bj)
#pragma unroll
                        for (int n = 0; n < 2; ++n) *(f32x4*)(hrow + bj * HALF + 16 * n) = acc[ai][bj][m][n];
                }
        } else if constexpr (MODE == EP_RES) {
            f32x4 sc[2][2];
#pragma unroll
            for (int bj = 0; bj < 2; ++bj)
#pragma unroll
                for (int n = 0; n < 2; ++n) sc[bj][n] = p0 ? *(const f32x4*)(p0 + colb + bj * HALF + 16 * n) : (f32x4){1.f, 1.f, 1.f, 1.f};
#pragma unroll
            for (int ai = 0; ai < 2; ++ai)
#pragma unroll
                for (int m = 0; m < 4; ++m) {
                    float* hrow = (float*)o0 + (size_t)(rowb + ai * HALF + m * 16) * 1024 + colb;
                    f32x4 hv[2][2];
#pragma unroll
                    for (int bj = 0; bj < 2; ++bj)
#pragma unroll
                        for (int n = 0; n < 2; ++n) hv[bj][n] = *(const f32x4*)(hrow + bj * HALF + 16 * n);
#pragma unroll
                    for (int bj = 0; bj < 2; ++bj)
#pragma unroll
                        for (int n = 0; n < 2; ++n) *(f32x4*)(hrow + bj * HALF + 16 * n) = hv[bj][n] + acc[ai][bj][m][n] * sc[bj][n];
                }
        } else if constexpr (MODE == EP_LORA2) {
            const int grp = u.pn >> 2;
            const float* bp = (grp == 0) ? p0 : p1;
#pragma unroll
            for (int ai = 0; ai < 2; ++ai)
#pragma unroll
                for (int m = 0; m < 4; ++m) {
                    const int row = rowb + ai * HALF + m * 16;
                    f32x4 bias[2][2];
#pragma unroll
                    for (int bj = 0; bj < 2; ++bj)
#pragma unroll
                        for (int n = 0; n < 2; ++n) bias[bj][n] = (grp < 2) ? *(const f32x4*)(bp + ((colb + bj * HALF + 4 * n) & 1023)) : (f32x4){0.f, 0.f, 0.f, 0.f};
#pragma unroll
                    for (int bj = 0; bj < 2; ++bj)
#pragma unroll
                        for (int n = 0; n < 2; ++n) {
                            f32x4 v = acc[ai][bj][m][n] + bias[bj][n];
                            if (grp == 0) {
#pragma unroll
                                for (int j = 0; j < 4; ++j) { const float wl = -softplusf_(-v[j]) - 0.5f; v[j] = -fexp(wl); } }
                            else if (grp == 1) {
#pragma unroll
                                for (int j = 0; j < 4; ++j) v[j] = sigmoidf_(v[j]); }
                            *(h16x4*)((h16*)o0 + (size_t)row * 3072 + colb + bj * HALF + 4 * n) = h4(v);
                        }
                }
        } else if constexpr (MODE == EP_UP) {
#pragma unroll
            for (int ai = 0; ai < 2; ++ai)
#pragma unroll
                for (int m = 0; m < 4; ++m) {
                    bf16_t* orow = (bf16_t*)o0 + (size_t)(rowb + ai * HALF + m * 16) * 4096 + colb;
#pragma unroll
                    for (int bj = 0; bj < 2; ++bj) {
                        f32x4 v0 = acc[ai][bj][m][0], v1 = acc[ai][bj][m][1];
#pragma unroll
                        for (int j = 0; j < 4; ++j) { const float r0 = fmaxf(v0[j], 0.f), r1 = fmaxf(v1[j], 0.f); v0[j] = r0 * r0; v1[j] = r1 * r1; }
                        *(u32x4*)(orow + bj * HALF) = (u32x4){pk2(v0[0], v0[1]), pk2(v0[2], v0[3]), pk2(v1[0], v1[1]), pk2(v1[2], v1[3])};
                    }
                }
        } else if constexpr (MODE == EP_Z || MODE == EP_RKV) {
            if (u.pn < 12) {
#pragma unroll
                for (int ai = 0; ai < 2; ++ai)
#pragma unroll
                    for (int m = 0; m < 4; ++m) {
                        h16* orow = (h16*)o0 + (size_t)(rowb + ai * HALF + m * 16) * 3072 + colb;
#pragma unroll
                        for (int bj = 0; bj < 2; ++bj) {
                            const f32x4 v0 = acc[ai][bj][m][0], v1 = acc[ai][bj][m][1];
                            h16x8 o; o[0] = (h16)v0[0]; o[1] = (h16)v0[1]; o[2] = (h16)v0[2]; o[3] = (h16)v0[3]; o[4] = (h16)v1[0]; o[5] = (h16)v1[1]; o[6] = (h16)v1[2]; o[7] = (h16)v1[3];
                            *(h16x8*)(orow + bj * HALF) = o;
                        }
                    }
            } else {
#pragma unroll
                for (int ai = 0; ai < 2; ++ai)
#pragma unroll
                    for (int m = 0; m < 4; ++m) {
                        const int row = rowb + ai * HALF + m * 16;
#pragma unroll
                        for (int bj = 0; bj < 2; ++bj)
#pragma unroll
                            for (int n = 0; n < 2; ++n) put<false>(row, colb + bj * HALF + 4 * n, acc[ai][bj][m][n]);
                    }
            }
        } else {
#pragma unroll
            for (int ai = 0; ai < 2; ++ai)
#pragma unroll
                for (int m = 0; m < 4; ++m) {
                    const int row = rowb + ai * HALF + m * 16;
#pragma unroll
                    for (int bj = 0; bj < 2; ++bj)
#pragma unroll
                        for (int n = 0; n < 2; ++n) put<false>(row, colb + bj * HALF + (PERM ? 4 * n : 16 * n), acc[ai][bj][m][n]);
                }
        }
    }
};
template <int MODE, bool ATOMIC>
__device__ __forceinline__ void thin_gemm(int lane, int wave, const Gemm g, int N, int ksplit, const Epi<MODE>& E, unsigned char* ldsb) {
    const int ntn = N >> 4, ntasks = ntn * ksplit, kl = g.K / ksplit, kw = kl >> 3, ns = kw >> 5;
    const int fr = lane & 15, fq = lane >> 4;
    f32x4* red = (f32x4*)ldsb;
    for (int task = blockIdx.x; task < ntasks; task += gridDim.x) {
        const int nt = task % ntn, ks = task / ntn, n0 = nt * 16, k0 = ks * kl + wave * kw;
        const bf16_t* ap = (const bf16_t*)((const char*)g.A + (size_t)((n0 >> 8) >> g.grp_shift) * g.a_grp_bytes) + (size_t)(NPROMPT + fr) * g.lda + k0 + fq * 8;
        const bf16_t* bp = g.Bt + (size_t)(n0 + fr) * g.ldb + k0 + fq * 8;
        const size_t tstride = (size_t)16 * g.lda;
        f32x4 acc[8];
#pragma unroll
        for (int mt = 0; mt < 8; ++mt) acc[mt] = (f32x4){0.f, 0.f, 0.f, 0.f};
        for (int s = 0; s < ns; s += 2) {
            const bool two = (s + 1 < ns);
            bf16x8 b0, b1, a0[8], a1[8];
            b0 = *(const bf16x8*)(bp + 32 * s);
#pragma unroll
            for (int mt = 0; mt < 8; ++mt) a0[mt] = *(const bf16x8*)(ap + mt * tstride + 32 * s);
            if (two) { b1 = *(const bf16x8*)(bp + 32 * s + 32);
#pragma unroll
                for (int mt = 0; mt < 8; ++mt) a1[mt] = *(const bf16x8*)(ap + mt * tstride + 32 * s + 32); }
#pragma unroll
            for (int mt = 0; mt < 8; ++mt) acc[mt] = __builtin_amdgcn_mfma_f32_16x16x32_bf16(b0, a0[mt], acc[mt], 0, 0, 0);
            if (two) {
#pragma unroll
                for (int mt = 0; mt < 8; ++mt) acc[mt] = __builtin_amdgcn_mfma_f32_16x16x32_bf16(b1, a1[mt], acc[mt], 0, 0, 0); }
        }
        __syncthreads();
#pragma unroll
        for (int mt = 0; mt < 8; ++mt) red[(wave * 8 + mt) * 64 + lane] = acc[mt];
        __syncthreads();
        f32x4 sum = red[(0 * 8 + wave) * 64 + lane];
#pragma unroll
        for (int w = 1; w < 8; ++w) sum += red[(w * 8 + wave) * 64 + lane];
        E.template put<ATOMIC>(NPROMPT + wave * 16 + fr, n0 + fq * 4, sum);
    }
}
__device__ __forceinline__ void gl_direct(int lane, int gw, int NGW, const bf16_t* XN, const bf16_t* Bt, float* GL) {
    const int fr = lane & 15, fq = lane >> 4;
    const bf16_t* bp = Bt + (size_t)(3072 + fr) * 1024 + fq * 8;
    for (int mt = gw; mt < NPROMPT / 16; mt += NGW) {
        const bf16_t* ap = XN + (size_t)(mt * 16 + fr) * 1024 + fq * 8;
        f32x4 acc = (f32x4){0.f, 0.f, 0.f, 0.f};
        for (int kk = 0; kk < 1024; kk += 256) {
            bf16x8 a[8], b[8];
#pragma unroll
            for (int i = 0; i < 8; ++i) { a[i] = *(const bf16x8*)(ap + kk + 32 * i); b[i] = *(const bf16x8*)(bp + kk + 32 * i); }
#pragma unroll
            for (int i = 0; i < 8; ++i) acc = __builtin_amdgcn_mfma_f32_16x16x32_bf16(b[i], a[i], acc, 0, 0, 0);
        }
        *(f32x4*)(GL + (size_t)(mt * 16 + fr) * 16 + fq * 4) = acc;
    }
}
}

struct Ctx { int tid, lane, wave, gw, NGW; };

__device__ __forceinline__ void wprep(const Ctx& c, LAS float* scr, int& base, const float* src, int Ks, int Ns, int lsrc, bf16_t* dst, int Kd, int Nd, int ldd, int roff, int coff, const float* mu, int mode) {
    const int nblk = Nd / 32, nitems = (Kd / 64) * nblk;
    int first = (c.gw - (base % c.NGW) + c.NGW) % c.NGW;
    base += nitems;
    const int lane = c.lane;
    for (int it = first; it < nitems; it += c.NGW) {
        const int kb = it / nblk, nb = it % nblk, k0 = 64 * kb, n0 = 32 * nb;
        const int kr = lane >> 3, n4 = (lane & 7) * 4, n = n0 + n4;
        f32x4 v[8];
#pragma unroll
        for (int i = 0; i < 8; ++i) {
            const int k = k0 + kr + 8 * i;
            v[i] = (f32x4){0.f, 0.f, 0.f, 0.f};
            if (k < Ks && n < Ns) { v[i] = *(const f32x4*)(src + (size_t)k * lsrc + n); if (mode == 1) v[i] = v[i] * mu[k]; else if (mode == 2) v[i] = v[i] * (1.0f - mu[k]); else if (mode == 3) v[i] = v[i] * *(const f32x4*)(mu + n); }
        }
#pragma unroll
        for (int i = 0; i < 8; ++i) { LAS float* d = scr + (kr + 8 * i) * 33 + n4; d[0] = v[i][0]; d[1] = v[i][1]; d[2] = v[i][2]; d[3] = v[i][3]; }
        LDS_WAIT();
        const int cc = lane & 7;
#pragma unroll
        for (int j = 0; j < 4; ++j) { const int nn = (lane >> 3) + 8 * j; const LAS float* s = scr + (8 * cc) * 33 + nn;
            u32x4 o; o.x = pk2(s[0 * 33], s[1 * 33]); o.y = pk2(s[2 * 33], s[3 * 33]); o.z = pk2(s[4 * 33], s[5 * 33]); o.w = pk2(s[6 * 33], s[7 * 33]);
            *(u32x4*)(dst + (size_t)(roff + n0 + nn) * ldd + coff + k0 + 8 * cc) = o; }
        LDS_WAIT();
    }
}
__device__ __forceinline__ void wprep_ffn(const Ctx& c, LAS float* scr, int& base, const Params& P, int l) {
    wprep(c, scr, base, P.in(10) + (size_t)l * 4194304, 1024, 4096, 4096, (bf16_t*)(P.ws + R_W + W_UP), 1024, 4096, 1024, 0, 0, nullptr, 0);
    wprep(c, scr, base, P.in(11) + (size_t)l * 4194304, 4096, 1024, 1024, (bf16_t*)(P.ws + R_W + W_DOWN), 4096, 1024, 4096, 0, 0, nullptr, 0);
}

__device__ __forceinline__ float load_row_rstd(const float* xr, int lane, f32x4 (&v)[4], float eps) {
    float s = 0.f;
#pragma unroll
    for (int j = 0; j < 4; ++j) { v[j] = *(const f32x4*)(xr + lane * 4 + 256 * j); s += (v[j][0] * v[j][0] + v[j][1] * v[j][1]) + (v[j][2] * v[j][2] + v[j][3] * v[j][3]); }
    return 1.0f / sqrtf(wave_sum(s) * (1.0f / 1024.0f) + eps);
}

template <bool TOF32>
__device__ __forceinline__ void norm_rows(const Ctx& c, const float* h, const float* g, bf16_t* XN, float* F32) {
    f32x4 v[4], vn[4], gg[4];
#pragma unroll
    for (int j = 0; j < 4; ++j) gg[j] = *(const f32x4*)(g + c.lane * 4 + 256 * j);
    int m = c.gw;
    if (m < MREAL) {
#pragma unroll
        for (int j = 0; j < 4; ++j) v[j] = *(const f32x4*)(h + (size_t)m * 1024 + c.lane * 4 + 256 * j); }
    while (m < MREAL) {
        const int mn = m + c.NGW;
        if (mn < MREAL) {
#pragma unroll
            for (int j = 0; j < 4; ++j) vn[j] = *(const f32x4*)(h + (size_t)mn * 1024 + c.lane * 4 + 256 * j); }
        float ssq = 0.f;
#pragma unroll
        for (int j = 0; j < 4; ++j) ssq += (v[j][0] * v[j][0] + v[j][1] * v[j][1]) + (v[j][2] * v[j][2] + v[j][3] * v[j][3]);
        const float rstd = 1.0f / sqrtf(wave_sum(ssq) * (1.0f / 1024.0f) + 1e-6f);
#pragma unroll
        for (int j = 0; j < 4; ++j) {
            const f32x4 y = v[j] * rstd * gg[j];
            if constexpr (TOF32) *(f32x4*)(F32 + (size_t)m * 1024 + c.lane * 4 + 256 * j) = y;
            else *(u32x2*)(XN + (size_t)m * 1024 + c.lane * 4 + 256 * j) = pk4(y);
        }
#pragma unroll
        for (int j = 0; j < 4; ++j) v[j] = vn[j];
        m = mn;
    }
}
__device__ __forceinline__ void norm_to_xn(const Ctx& c, const float* h, const float* g, bf16_t* XN) { norm_rows<false>(c, h, g, XN, nullptr); }

__device__ __forceinline__ void rwkv_prep(const Ctx& c, const Params& P) {
    float* h = P.out; bf16_t* U2 = (bf16_t*)(P.ws + R_BIG + B_U2);
    const float* g = P.in(7); const float* xp = P.in(0); const float* xs = P.in(1); const float* shs = P.in(3);
    f32x4 v[4], vn[4], gg[4];
#pragma unroll
    for (int j = 0; j < 4; ++j) gg[j] = *(const f32x4*)(g + c.lane * 4 + 256 * j);
    int m = c.gw;
    if (m < MREAL) { const float* xr = m < NPROMPT ? xp + (size_t)m * 1024 : xs + (size_t)(m - NPROMPT) * 1024;
#pragma unroll
        for (int j = 0; j < 4; ++j) v[j] = *(const f32x4*)(xr + c.lane * 4 + 256 * j); }
    while (m < MREAL) {
        const int mn = m + c.NGW;
        if (mn < MREAL) { const float* xr = mn < NPROMPT ? xp + (size_t)mn * 1024 : xs + (size_t)(mn - NPROMPT) * 1024;
#pragma unroll
            for (int j = 0; j < 4; ++j) vn[j] = *(const f32x4*)(xr + c.lane * 4 + 256 * j); }
        bf16_t* u2 = U2 + (size_t)m * 2048 + c.lane * 4;
        float ssq = 0.f;
#pragma unroll
        for (int j = 0; j < 4; ++j) ssq += (v[j][0] * v[j][0] + v[j][1] * v[j][1]) + (v[j][2] * v[j][2] + v[j][3] * v[j][3]);
        const float rstd = 1.0f / sqrtf(wave_sum(ssq) * (1.0f / 1024.0f) + 1e-6f);
#pragma unroll
        for (int j = 0; j < 4; ++j) {
            const int col = c.lane * 4 + 256 * j;
            if (m >= NPROMPT) *(f32x4*)(h + (size_t)m * 1024 + col) = v[j];
            const f32x4 u = v[j] * rstd * gg[j];
            const u32x2 ub = pk4(u);
            *(u32x2*)(u2 + 256 * j) = ub;
            if (m < NPROMPT) {
                const int t = m & 2047, b = m >> 11;
                if (t < 2047) *(u32x2*)(u2 + 2048 + 1024 + 256 * j) = ub; else *(f32x4*)(P.out + O_SHP + (size_t)b * 1024 + col) = u;
                if (t == 0) *(u32x2*)(u2 + 1024 + 256 * j) = pk4(u * 0.0f);
            } else {
                const int b = m - NPROMPT;
                *(u32x2*)(u2 + 1024 + 256 * j) = pk4(*(const f32x4*)(shs + (size_t)b * 1024 + col));
                *(f32x4*)(P.out + O_SHS + (size_t)b * 1024 + col) = u;
            }
        }
#pragma unroll
        for (int j = 0; j < 4; ++j) v[j] = vn[j];
        m = mn;
    }
}
__device__ __forceinline__ void rwkv_wprep(const Ctx& c, LAS float* scr, const Params& P) {
    int base = 0;
    bf16_t* B1 = (bf16_t*)(P.ws + R_W + W_MIX1); bf16_t* B2 = (bf16_t*)(P.ws + R_W + W_MIX2);
    const float* mu = P.in(12);
    wprep(c, scr, base, P.in(13) + 0 * 1048576, 1024, 1024, 1024, B1, 1024, 1024, 2048, 0, 0, mu + 0 * 1024, 2);
    wprep(c, scr, base, P.in(13) + 0 * 1048576, 1024, 1024, 1024, B1, 1024, 1024, 2048, 0, 1024, mu + 0 * 1024, 1);
    wprep(c, scr, base, P.in(13) + 1 * 1048576, 1024, 1024, 1024, B1, 1024, 1024, 2048, 1024, 0, mu + 2 * 1024, 2);
    wprep(c, scr, base, P.in(13) + 1 * 1048576, 1024, 1024, 1024, B1, 1024, 1024, 2048, 1024, 1024, mu + 2 * 1024, 1);
    wprep(c, scr, base, P.in(13) + 2 * 1048576, 1024, 1024, 1024, B1, 1024, 1024, 2048, 2048, 0, mu + 3 * 1024, 2);
    wprep(c, scr, base, P.in(13) + 2 * 1048576, 1024, 1024, 1024, B1, 1024, 1024, 2048, 2048, 1024, mu + 3 * 1024, 1);
    wprep(c, scr, base, P.in(15), 1024, 64, 64, B1, 1024, 256, 2048, 3072, 0, mu + 1 * 1024, 2);
    wprep(c, scr, base, P.in(15), 1024, 64, 64, B1, 1024, 256, 2048, 3072, 1024, mu + 1 * 1024, 1);
    wprep(c, scr, base, P.in(18), 1024, 64, 64, B1, 1024, 256, 2048, 3328, 0, mu + 4 * 1024, 2);
    wprep(c, scr, base, P.in(18), 1024, 64, 64, B1, 1024, 256, 2048, 3328, 1024, mu + 4 * 1024, 1);
    wprep(c, scr, base, P.in(20), 1024, 160, 160, B1, 1024, 256, 2048, 3584, 0, mu + 5 * 1024, 2);
    wprep(c, scr, base, P.in(20), 1024, 160, 160, B1, 1024, 256, 2048, 3584, 1024, mu + 5 * 1024, 1);
    wprep(c, scr, base, P.in(16), 64, 1024, 1024, B2, 256, 1024, 256, 0, 0, nullptr, 0);
    wprep(c, scr, base, P.in(19), 64, 1024, 1024, B2, 256, 1024, 256, 1024, 0, nullptr, 0);
    wprep(c, scr, base, P.in(21), 160, 1024, 1024, B2, 256, 1024, 256, 2048, 0, nullptr, 0);
    wprep(c, scr, base, P.in(27), 1024, 1024, 1024, (bf16_t*)(P.ws + R_W + W_WO), 1024, 1024, 1024, 0, 0, nullptr, 0);
    wprep_ffn(c, scr, base, P, 0);
}

struct RwkvVec { f32x4 r, w, k, na, b; };
__device__ __forceinline__ RwkvVec rwkv_derive(const Params& P, f32x4 r, f32x4 k, f32x4 wl, f32x4 a, int c4) {
    const f32x4 kk0 = k * *(const f32x4*)(P.in(22) + c4);
    const float ss = reduce16((kk0[0] * kk0[0] + kk0[1] * kk0[1]) + (kk0[2] * kk0[2] + kk0[3] * kk0[3]));
    const float inv = 1.0f / fmaxf(sqrtf(ss), 1e-12f);
    const f32x4 kk = kk0 * inv;
    const f32x4 ka = *(const f32x4*)(P.in(23) + c4);
    RwkvVec o;
    o.r = r;
    o.k = k * (1.0f + (a - 1.0f) * ka);
    o.b = kk * a;
    o.na = -kk;
#pragma unroll
    for (int j = 0; j < 4; ++j) o.w[j] = fexp(wl[j]);
    return o;
}

__device__ __forceinline__ float reduce8(float v) {
    v += dppmov<0xB1>(v); v += dppmov<0x4E>(v); v += dppmov<0x141>(v); return v;
}
__device__ __forceinline__ void rwkv_scan(const Ctx& c, const Params& P, unsigned char* ldsb) {
    const h16* RKV = (const h16*)(P.ws + R_BIG + B_RKV); const h16* WAG = (const h16*)(P.ws + R_BIG + B_WAG); h16* Y = (h16*)(P.ws + R_BIG + B_Y);
    constexpr int T = 32, NC = SEQ / T;
    constexpr int BUF_FLOATS = 5 * T * 64 + T * 32, YP_FLOATS = T * 32 * 8;
    float* L = (float*)ldsb;
    float* YpB = L + 2 * BUF_FLOATS;
    const int tid = c.tid, lane = c.lane, wave = c.wave;
    const int rr = (wave & 3) * 8 + (lane >> 3), kq = lane & 7;
    const int t2 = tid & 255, pt = t2 >> 4, pc = (t2 & 15) * 4;
    for (int task = blockIdx.x; task < 256; task += gridDim.x) {
        const int chain = task >> 1, half = task & 1, b = chain >> 4, hd = chain & 15;
        const int vrow = half * 32 + rr;
        const int c4 = hd * 64 + pc;
        f32x4 S0 = (f32x4){0.f, 0.f, 0.f, 0.f}, S1 = S0;
        h16x4 pr0, pk0, pv0, pw0, pa0, pr1, pk1, pv1, pw1, pa1;
        const f32x4 kkw = *(const f32x4*)(P.in(22) + c4), kaw = *(const f32x4*)(P.in(23) + c4);
#define RW_ISSUE(ch) do { const size_t m_ = (size_t)b * SEQ + (ch) * T + pt; \
            pr0 = *(const h16x4*)(RKV + m_ * 3072 + c4); pk0 = *(const h16x4*)(RKV + m_ * 3072 + 1024 + c4); pv0 = *(const h16x4*)(RKV + m_ * 3072 + 2048 + c4); \
            pw0 = *(const h16x4*)(WAG + m_ * 3072 + c4); pa0 = *(const h16x4*)(WAG + m_ * 3072 + 1024 + c4); \
            pr1 = *(const h16x4*)(RKV + (m_ + 16) * 3072 + c4); pk1 = *(const h16x4*)(RKV + (m_ + 16) * 3072 + 1024 + c4); pv1 = *(const h16x4*)(RKV + (m_ + 16) * 3072 + 2048 + c4); \
            pw1 = *(const h16x4*)(WAG + (m_ + 16) * 3072 + c4); pa1 = *(const h16x4*)(WAG + (m_ + 16) * 3072 + 1024 + c4); } while (0)
#define RW_DERIVE1(B_, tt_, r_, k_, v_, w_, a_) do { const f32x4 kf_ = f4(k_), af_ = f4(a_), wf_ = f4(w_); const f32x4 kk0_ = kf_ * kkw; \
            const float ss_ = reduce16((kk0_[0] * kk0_[0] + kk0_[1] * kk0_[1]) + (kk0_[2] * kk0_[2] + kk0_[3] * kk0_[3])); \
            const f32x4 kk_ = kk0_ * (1.0f / fmaxf(sqrtf(ss_), 1e-12f)); \
            f32x4 wd_; wd_[0] = fexp(wf_[0]); wd_[1] = fexp(wf_[1]); wd_[2] = fexp(wf_[2]); wd_[3] = fexp(wf_[3]); \
            *(f32x4*)(B_ + 0 * T * 64 + (tt_) * 64 + pc) = f4(r_); *(f32x4*)(B_ + 1 * T * 64 + (tt_) * 64 + pc) = wd_; \
            *(f32x4*)(B_ + 2 * T * 64 + (tt_) * 64 + pc) = kf_ * (1.0f + (af_ - 1.0f) * kaw); \
            *(f32x4*)(B_ + 3 * T * 64 + (tt_) * 64 + pc) = -kk_; *(f32x4*)(B_ + 4 * T * 64 + (tt_) * 64 + pc) = kk_ * af_; \
            if ((pc >> 5) == half) *(f32x4*)(B_ + 5 * T * 64 + (tt_) * 32 + (pc & 31)) = f4(v_); } while (0)
#define RW_DERIVE(buf) do { float* Bd_ = L + (buf) * BUF_FLOATS; RW_DERIVE1(Bd_, pt, pr0, pk0, pv0, pw0, pa0); RW_DERIVE1(Bd_, pt + 16, pr1, pk1, pv1, pw1, pa1); } while (0)
#define RW_YOUT(ch, ybuf) do { const float* Yq_ = YpB + (ybuf) * YP_FLOATS; _Pragma("unroll") for (int e_ = 0; e_ < 2; ++e_) { \
            const int tt_ = (t2 >> 4) + 16 * e_, r2_ = (t2 & 15) * 2; const float* yp_ = Yq_ + (tt_ * 32 + r2_) * 8; \
            const f32x4 s0_ = *(const f32x4*)(yp_) + *(const f32x4*)(yp_ + 4), s1_ = *(const f32x4*)(yp_ + 8) + *(const f32x4*)(yp_ + 12); \
            h16x2 o_; o_[0] = (h16)((s0_[0] + s0_[1]) + (s0_[2] + s0_[3])); o_[1] = (h16)((s1_[0] + s1_[1]) + (s1_[2] + s1_[3])); \
            *(h16x2*)(Y + ((size_t)b * SEQ + (ch) * T + tt_) * 1024 + hd * 64 + half * 32 + r2_) = o_; } } while (0)
#define RW_LOAD(X, arr, tt_) do { X##0 = *(const f32x4*)(B + (arr) * T * 64 + (tt_) * 64 + kq * 8); X##1 = *(const f32x4*)(B + (arr) * T * 64 + (tt_) * 64 + kq * 8 + 4); } while (0)
#define RW_DOT(a, b) (((a##0[0] * b##0[0] + a##0[1] * b##0[1]) + (a##0[2] * b##0[2] + a##0[3] * b##0[3])) + ((a##1[0] * b##1[0] + a##1[1] * b##1[1]) + (a##1[2] * b##1[2] + a##1[3] * b##1[3])))
        __syncthreads();
        if (wave >= 4) { RW_ISSUE(0); RW_DERIVE(0); RW_ISSUE(1); }
        __syncthreads();
        for (int ch = 0; ch < NC; ++ch) {
            const int buf = ch & 1;
            if (wave < 4) {
                __builtin_amdgcn_s_setprio(3);
                const float* B = L + buf * BUF_FLOATS;
                float* Yp = YpB + buf * YP_FLOATS;
#define LO2(v) __builtin_shufflevector(v, v, 0, 1)
#define HI2(v) __builtin_shufflevector(v, v, 2, 3)
#define RW_LD4(a, b, c, d, arr, tt_) do { const f32x4 x0_ = *(const f32x4*)(B + (arr) * T * 64 + (tt_) * 64 + kq * 8), x1_ = *(const f32x4*)(B + (arr) * T * 64 + (tt_) * 64 + kq * 8 + 4); \
                    a = LO2(x0_); b = HI2(x0_); c = LO2(x1_); d = HI2(x1_); } while (0)
                f32x2 na0, na1, na2, na3, w0, w1, w2, w3, kv0, kv1, kv2, kv3, bb0, bb1, bb2, bb3, rv0, rv1, rv2, rv3; float vv;
                RW_LD4(na0, na1, na2, na3, 3, 0); RW_LD4(w0, w1, w2, w3, 1, 0); RW_LD4(kv0, kv1, kv2, kv3, 2, 0); RW_LD4(bb0, bb1, bb2, bb3, 4, 0); RW_LD4(rv0, rv1, rv2, rv3, 0, 0); vv = B[5 * T * 64 + rr];
                f32x2 Sa = LO2(S0), Sb = HI2(S0), Sc = LO2(S1), Sd = HI2(S1);
#pragma unroll 4
                for (int tt = 0; tt < T; ++tt) {
                    f32x2 xna0, xna1, xna2, xna3, xw0, xw1, xw2, xw3, xkv0, xkv1, xkv2, xkv3, xbb0, xbb1, xbb2, xbb3, xrv0, xrv1, xrv2, xrv3; float xvv;
                    const int tn = (tt + 1 < T) ? tt + 1 : tt;
                    RW_LD4(xna0, xna1, xna2, xna3, 3, tn); RW_LD4(xw0, xw1, xw2, xw3, 1, tn); RW_LD4(xkv0, xkv1, xkv2, xkv3, 2, tn); RW_LD4(xbb0, xbb1, xbb2, xbb3, 4, tn); RW_LD4(xrv0, xrv1, xrv2, xrv3, 0, tn);
                    xvv = B[5 * T * 64 + tn * 32 + rr];
                    f32x2 p = Sa * na0; p = Sb * na1 + p; p = Sc * na2 + p; p = Sd * na3 + p;
                    const float sa = reduce8(p[0] + p[1]);
                    Sa = Sa * w0 + (bb0 * sa + kv0 * vv); Sb = Sb * w1 + (bb1 * sa + kv1 * vv); Sc = Sc * w2 + (bb2 * sa + kv2 * vv); Sd = Sd * w3 + (bb3 * sa + kv3 * vv);
                    f32x2 q = Sa * rv0; q = Sb * rv1 + q; q = Sc * rv2 + q; q = Sd * rv3 + q;
                    Yp[(tt * 32 + rr) * 8 + kq] = q[0] + q[1];
                    na0 = xna0; na1 = xna1; na2 = xna2; na3 = xna3; w0 = xw0; w1 = xw1; w2 = xw2; w3 = xw3; kv0 = xkv0; kv1 = xkv1; kv2 = xkv2; kv3 = xkv3;
                    bb0 = xbb0; bb1 = xbb1; bb2 = xbb2; bb3 = xbb3; rv0 = xrv0; rv1 = xrv1; rv2 = xrv2; rv3 = xrv3; vv = xvv;
                }
                S0 = (f32x4){Sa[0], Sa[1], Sb[0], Sb[1]}; S1 = (f32x4){Sc[0], Sc[1], Sd[0], Sd[1]};
                __builtin_amdgcn_s_setprio(0);
#undef LO2
#undef HI2
#undef RW_LD4
            } else {
                if (ch > 0) RW_YOUT(ch - 1, buf ^ 1);
                if (ch + 1 < NC) { RW_DERIVE(buf ^ 1); if (ch + 2 < NC) RW_ISSUE(ch + 2); }
            }
            LDS_BARRIER();
        }
        if (wave >= 4) RW_YOUT(NC - 1, (NC - 1) & 1);
        else {
            float* so = P.out + O_WKVP + ((size_t)(b * 16 + hd) * 64 + vrow) * 64 + kq * 8;
            *(f32x4*)so = S0; *(f32x4*)(so + 4) = S1;
        }
#undef RW_ISSUE
#undef RW_DERIVE1
#undef RW_DERIVE
#undef RW_YOUT
#undef RW_LOAD
#undef RW_DOT
    }
    {
        const int kq16 = lane & 15;
        const float* st_in = P.in(2); const float* kkp = P.in(22); const float* kap = P.in(23);
        for (int wt0 = c.gw; wt0 < NSB * 16 * 16; wt0 += 4 * c.NGW) {
            f32x4 r[4], k[4], wl[4], a[4], S[4]; float vv[4]; size_t so[4]; int c4v[4]; bool ok[4];
#pragma unroll
            for (int e = 0; e < 4; ++e) {
                const int wt = wt0 + e * c.NGW; ok[e] = wt < NSB * 16 * 16;
                const int wtc = ok[e] ? wt : wt0;
                const int pair = wtc >> 4, rg = wtc & 15, b = pair >> 4, hd = pair & 15;
                const int vrow = rg * 4 + (lane >> 4); c4v[e] = hd * 64 + kq16 * 4;
                const size_t m = (size_t)NPROMPT + b;
                r[e] = f4(*(const h16x4*)(RKV + m * 3072 + c4v[e])); k[e] = f4(*(const h16x4*)(RKV + m * 3072 + 1024 + c4v[e]));
                vv[e] = (float)RKV[m * 3072 + 2048 + hd * 64 + vrow];
                wl[e] = f4(*(const h16x4*)(WAG + m * 3072 + c4v[e])); a[e] = f4(*(const h16x4*)(WAG + m * 3072 + 1024 + c4v[e]));
                so[e] = ((size_t)(b * 16 + hd) * 64 + vrow) * 64 + kq16 * 4;
                S[e] = *(const f32x4*)(st_in + so[e]);
            }
#pragma unroll
            for (int e = 0; e < 4; ++e) {
                const f32x4 kk0 = k[e] * *(const f32x4*)(kkp + c4v[e]);
                const float ss = reduce16((kk0[0] * kk0[0] + kk0[1] * kk0[1]) + (kk0[2] * kk0[2] + kk0[3] * kk0[3]));
                const f32x4 kk = kk0 * (1.0f / fmaxf(sqrtf(ss), 1e-12f));
                const f32x4 kp = k[e] * (1.0f + (a[e] - 1.0f) * *(const f32x4*)(kap + c4v[e]));
                f32x4 wd; wd[0] = fexp(wl[e][0]); wd[1] = fexp(wl[e][1]); wd[2] = fexp(wl[e][2]); wd[3] = fexp(wl[e][3]);
                f32x4 Sx = S[e];
                const float sa = -reduce16((Sx[0] * kk[0] + Sx[1] * kk[1]) + (Sx[2] * kk[2] + Sx[3] * kk[3]));
                Sx = Sx * wd + ((kk * a[e]) * sa + kp * vv[e]);
                const float y = reduce16((Sx[0] * r[e][0] + Sx[1] * r[e][1]) + (Sx[2] * r[e][2] + Sx[3] * r[e][3]));
                if (ok[e]) {
                    *(f32x4*)(P.out + O_WKVS + so[e]) = Sx;
                    if (kq16 == 0) Y[((size_t)NPROMPT + (so[e] >> 16)) * 1024 + ((so[e] >> 6) & 1023)] = (h16)y;
                }
            }
        }
    }
}

__device__ __forceinline__ void rwkv_post(const Ctx& c, const Params& P) {
    const h16* RKV = (const h16*)(P.ws + R_BIG + B_RKV); const h16* WAG = (const h16*)(P.ws + R_BIG + B_WAG); const h16* Y = (const h16*)(P.ws + R_BIG + B_Y);
    bf16_t* XN = (bf16_t*)(P.ws + R_XN);
    const float* pka = P.in(23); const float* prk = P.in(24); const float* plw = P.in(25); const float* plb = P.in(26);
    f32x4 ka[4], rkw[4], lw[4], lb[4];
#pragma unroll
    for (int j = 0; j < 4; ++j) { const int col = c.lane * 4 + 256 * j; ka[j] = *(const f32x4*)(pka + col); rkw[j] = *(const f32x4*)(prk + col); lw[j] = *(const f32x4*)(plw + col); lb[j] = *(const f32x4*)(plb + col); }
#define RP_LOAD(X, m_) do { _Pragma("unroll") for (int j_ = 0; j_ < 4; ++j_) { const int col_ = c.lane * 4 + 256 * j_; \
        X##y[j_] = *(const h16x4*)(Y + (size_t)(m_) * 1024 + col_); X##r[j_] = *(const h16x4*)(RKV + (size_t)(m_) * 3072 + col_); X##k[j_] = *(const h16x4*)(RKV + (size_t)(m_) * 3072 + 1024 + col_); \
        X##v[j_] = *(const h16x4*)(RKV + (size_t)(m_) * 3072 + 2048 + col_); X##a[j_] = *(const h16x4*)(WAG + (size_t)(m_) * 3072 + 1024 + col_); X##g[j_] = *(const h16x4*)(WAG + (size_t)(m_) * 3072 + 2048 + col_); } } while (0)
    h16x4 cy[4], cr[4], ck[4], cv[4], ca[4], cg[4], ny[4], nr[4], nk[4], nv[4], na[4], ng[4];
    int m = c.gw;
    if (m < MREAL) RP_LOAD(c, m);
    while (m < MREAL) {
        const int mn = m + c.NGW;
        if (mn < MREAL) RP_LOAD(n, mn);
#pragma unroll
        for (int j = 0; j < 4; ++j) {
            const int col = c.lane * 4 + 256 * j;
            const f32x4 y = f4(cy[j]), r = f4(cr[j]), k = f4(ck[j]), v = f4(cv[j]), a = f4(ca[j]), g = f4(cg[j]);
            const float mean = reduce16((y[0] + y[1]) + (y[2] + y[3])) * (1.0f / 64.0f);
            const f32x4 dy = y - mean;
            const float var = reduce16((dy[0] * dy[0] + dy[1] * dy[1]) + (dy[2] * dy[2] + dy[3] * dy[3])) * (1.0f / 64.0f);
            const float rs = 1.0f / sqrtf(var + 64e-5f);
            const f32x4 kp = k * (1.0f + (a - 1.0f) * ka[j]);
            const f32x4 rk = r * kp * rkw[j];
            const float bon = reduce16((rk[0] + rk[1]) + (rk[2] + rk[3]));
            const f32x4 yn = dy * rs * lw[j] + lb[j];
            *(u32x2*)(XN + (size_t)m * 1024 + col) = pk4((yn + v * bon) * g);
        }
#pragma unroll
        for (int j = 0; j < 4; ++j) { cy[j] = ny[j]; cr[j] = nr[j]; ck[j] = nk[j]; cv[j] = nv[j]; ca[j] = na[j]; cg[j] = ng[j]; }
        m = mn;
    }
#undef RP_LOAD
}

__device__ __forceinline__ float gk_to_e(float x) {
    return fexp(-softplusf_(-x) * (1.0f / 16.0f));
}
__device__ __forceinline__ bf16x8 lds_frag(const bf16_t* base, int row, int ld, int k0) { return *(const bf16x8*)(base + row * ld + k0); }
constexpr size_t B_GREC = B_O + (size_t)MP * 1024 * 4;
constexpr int GREC_HEAD = 45568, GREC_BYTES = 45568 + 36864;
__device__ __forceinline__ void gla_pre(const Ctx& c, const Params& P, unsigned char* ldsb) {
    const h16* Z = (const h16*)(P.ws + R_BIG + B_Z); const float* GL = (const float*)(P.ws + R_BIG + B_GL);
    unsigned char* GREC = P.ws + R_BIG + B_GREC;
    constexpr int CH = 64, NC = SEQ / CH, LDQ = 136, LDT = 72;
    bf16_t* QB  = (bf16_t*)(ldsb);
    bf16_t* KBT = (bf16_t*)(ldsb + 17408);
    bf16_t* ATT = (bf16_t*)(ldsb + 35840);
    float* EL = (float*)(ldsb + 45056);
    bf16_t* KB  = (bf16_t*)(ldsb + 45568);
    h16* QR = (h16*)(ldsb + 62976);
    h16* KR = (h16*)(ldsb + 79360);
    float* GLs = (float*)(ldsb + 95744);
    float* SEG = (float*)(ldsb + 99840);
    bf16_t* VT = (bf16_t*)(ldsb + 101888);
    const int tid = c.tid, lane = c.lane, wave = c.wave;
    const int fr = lane & 15, fq = lane >> 4;
    const int kx = tid & 127, tq = tid >> 7;
    const int lt = tid >> 3, lks = (tid & 7) * 16, vsx = tid & 63, vg = tid >> 6, gt = tid >> 2, g4 = (tid & 3) * 4;
    for (int task = blockIdx.x; task < 32 * NC; task += gridDim.x) {
        const int chain = task / NC, n = task % NC, b = chain >> 2, hd = chain & 3;
        const size_t m0 = (size_t)b * SEQ + n * CH;
        float wg[16];
#pragma unroll
        for (int i = 0; i < 16; ++i) wg[i] = P.in(29)[(size_t)i * 512 + hd * 128 + kx];
        const float bg = P.in(30)[hd * 128 + kx];
        __syncthreads();
        *(h16x8*)(QR + lt * 128 + lks) = *(const h16x8*)(Z + (m0 + lt) * 3072 + hd * 128 + lks); *(h16x8*)(QR + lt * 128 + lks + 8) = *(const h16x8*)(Z + (m0 + lt) * 3072 + hd * 128 + lks + 8);
        *(h16x8*)(KR + lt * 128 + lks) = *(const h16x8*)(Z + (m0 + lt) * 3072 + 512 + hd * 128 + lks); *(h16x8*)(KR + lt * 128 + lks + 8) = *(const h16x8*)(Z + (m0 + lt) * 3072 + 512 + hd * 128 + lks + 8);
        if (tid < 256) *(f32x4*)(GLs + gt * 16 + g4) = *(const f32x4*)(GL + (m0 + gt) * 16 + g4);
#pragma unroll
        for (int i = 0; i < 4; ++i) {
            const h16x8 pv = *(const h16x8*)(Z + (m0 + vsx) * 3072 + 1024 + hd * 256 + vg * 32 + 8 * i);
#pragma unroll
            for (int j = 0; j < 8; ++j) VT[(vg * 32 + 8 * i + j) * LDT + vsx] = (bf16_t)f2bf((float)pv[j]);
        }
        __syncthreads();
        float cb[16]; float run = 0.f;
#pragma unroll
        for (int i = 0; i < 16; ++i) {
            const float* g = GLs + (tq * 16 + i) * 16;
            const f32x4 g0 = *(const f32x4*)g, g1 = *(const f32x4*)(g + 4), g2 = *(const f32x4*)(g + 8), g3 = *(const f32x4*)(g + 12);
            float x = bg;
#pragma unroll
            for (int j = 0; j < 4; ++j) x += g0[j] * wg[j] + g1[j] * wg[4 + j] + g2[j] * wg[8 + j] + g3[j] * wg[12 + j];
            run += -softplusf_(-x) * (1.0f / 16.0f);
            cb[i] = run;
        }
        SEG[tq * 128 + kx] = run;
        __syncthreads();
        {
            const float s0 = SEG[kx], s1 = SEG[128 + kx], s2 = SEG[256 + kx], s3 = SEG[384 + kx];
            const float off = (tq > 0 ? s0 : 0.f) + (tq > 1 ? s1 : 0.f) + (tq > 2 ? s2 : 0.f);
            unsigned kt[8];
#pragma unroll
            for (int i = 0; i < 16; ++i) {
                const int t = tq * 16 + i;
                const float bb = fmaxf(off + cb[i], -80.f);
                const float eb = fexp(bb), enb = __builtin_amdgcn_rcpf(eb);
                const float qv = (float)QR[t * 128 + kx] * 0.08838834764831845f * eb, kv = (float)KR[t * 128 + kx] * enb;
                QB[t * LDQ + kx] = (bf16_t)f2bf(qv);
                const unsigned kb = f2bf(kv);
                KB[t * LDQ + kx] = (bf16_t)kb;
                if (i & 1) kt[i >> 1] |= kb << 16; else kt[i >> 1] = kb;
            }
            *(u32x4*)(KBT + kx * LDT + tq * 16) = (u32x4){kt[0], kt[1], kt[2], kt[3]};
            *(u32x4*)(KBT + kx * LDT + tq * 16 + 8) = (u32x4){kt[4], kt[5], kt[6], kt[7]};
            if (tq == 0) EL[kx] = fexp(fmaxf((s0 + s1) + (s2 + s3), -80.f));
        }
        __syncthreads();
        {
            const int si = wave & 3;
#pragma unroll
            for (int tj = 0; tj < 2; ++tj) {
                const int ti = 2 * (wave >> 2) + tj;
                f32x4 acc = (f32x4){0.f, 0.f, 0.f, 0.f};
                if (si <= ti) {
#pragma unroll
                    for (int kk = 0; kk < 4; ++kk)
                        acc = __builtin_amdgcn_mfma_f32_16x16x32_bf16(lds_frag(KB, si * 16 + fr, LDQ, kk * 32 + fq * 8), lds_frag(QB, ti * 16 + fr, LDQ, kk * 32 + fq * 8), acc, 0, 0, 0);
                }
                const int t = ti * 16 + fr, sb = si * 16 + fq * 4;
#pragma unroll
                for (int j = 0; j < 4; ++j) if (sb + j > t) acc[j] = 0.f;
                *(u32x2*)(ATT + t * LDT + sb) = pk4(acc);
            }
        }
        __syncthreads();
        {
            unsigned char* rec = GREC + (size_t)task * GREC_BYTES;
            for (int u = tid; u < GREC_HEAD / 16; u += 512) *(u32x4*)(rec + u * 16) = *(const u32x4*)(ldsb + u * 16);
            for (int u = tid; u < 36864 / 16; u += 512) *(u32x4*)(rec + GREC_HEAD + u * 16) = *(const u32x4*)((const unsigned char*)VT + u * 16);
        }
    }
}
__device__ __forceinline__ void gla_scan(const Ctx& c, const Params& P, unsigned char* ldsb) {
    const h16* Z = (const h16*)(P.ws + R_BIG + B_Z); const float* GL = (const float*)(P.ws + R_BIG + B_GL); float* O = (float*)(P.ws + R_BIG + B_O);
    const unsigned char* GREC = P.ws + R_BIG + B_GREC;
    constexpr int CH = 64, NC = SEQ / CH, LDQ = 136, LDT = 72;
    bf16_t* QB  = (bf16_t*)(ldsb);
    bf16_t* KBT = (bf16_t*)(ldsb + 17408);
    bf16_t* ATT = (bf16_t*)(ldsb + 35840);
    float* EL = (float*)(ldsb + 45056);
    bf16_t* VT = (bf16_t*)(ldsb + 45568);
    bf16_t* ST = (bf16_t*)(ldsb + 50176);
    float* L = (float*)ldsb;
    float* LE = L; float* LK = L + 128; float* LQ = L + 256; float* LOP = L + 384;
    const int tid = c.tid, lane = c.lane, wave = c.wave;
    const int fr = lane & 15, fq = lane >> 4;
    for (int task = blockIdx.x; task < 256; task += gridDim.x) {
        const int chain = task >> 3, vs = task & 7, b = chain >> 2, hd = chain & 3;
        __syncthreads();
        for (int i = tid; i < 2 * 32 * LDQ / 2; i += 512) ((unsigned*)ST)[i] = 0u;
        f32x4 Sacc[2]; Sacc[0] = (f32x4){0.f, 0.f, 0.f, 0.f}; Sacc[1] = Sacc[0];
        u32x4 preA[7], preB[7];
#define GL_ISSUE(X, n) do { const unsigned char* rec_ = GREC + (size_t)(chain * NC + (n)) * GREC_BYTES; \
            _Pragma("unroll") for (int i_ = 0; i_ < 6; ++i_) { const int u_ = tid + 512 * i_; if (u_ < GREC_HEAD / 16) pre##X[i_] = *(const u32x4*)(rec_ + u_ * 16); } \
            if (tid < 288) pre##X[6] = *(const u32x4*)(rec_ + GREC_HEAD + vs * 4608 + tid * 16); } while (0)
#define GL_FILL(X) do { _Pragma("unroll") for (int i_ = 0; i_ < 6; ++i_) { const int u_ = tid + 512 * i_; if (u_ < GREC_HEAD / 16) *(u32x4*)(ldsb + u_ * 16) = pre##X[i_]; } \
            if (tid < 288) *(u32x4*)((unsigned char*)VT + tid * 16) = pre##X[6]; } while (0)
        GL_ISSUE(A, 0); GL_ISSUE(B, 1);
        int cur = 0;
        for (int n = 0; n < NC; ++n) {
            const size_t m0 = (size_t)b * SEQ + n * CH;
            if (n & 1) GL_FILL(B); else GL_FILL(A);
            LDS_BARRIER();
            if (n + 2 < NC) { if (n & 1) GL_ISSUE(B, n + 2); else GL_ISSUE(A, n + 2); }
            {
                const int ti = wave >> 1, vi = wave & 1;
                const bf16_t* STc = ST + cur * 32 * LDQ;
                f32x4 acc = (f32x4){0.f, 0.f, 0.f, 0.f};
#pragma unroll
                for (int kk = 0; kk < 4; ++kk)
                    acc = __builtin_amdgcn_mfma_f32_16x16x32_bf16(lds_frag(STc, vi * 16 + fr, LDQ, kk * 32 + fq * 8), lds_frag(QB, ti * 16 + fr, LDQ, kk * 32 + fq * 8), acc, 0, 0, 0);
#pragma unroll
                for (int kk = 0; kk < 2; ++kk)
                    acc = __builtin_amdgcn_mfma_f32_16x16x32_bf16(lds_frag(VT, vi * 16 + fr, LDT, kk * 32 + fq * 8), lds_frag(ATT, ti * 16 + fr, LDT, kk * 32 + fq * 8), acc, 0, 0, 0);
                *(f32x4*)(O + (m0 + ti * 16 + fr) * 1024 + hd * 256 + vs * 32 + vi * 16 + fq * 4) = acc;
            }
            {
                bf16_t* STn = ST + (cur ^ 1) * 32 * LDQ;
                const f32x4 el = *(const f32x4*)(EL + wave * 16 + fq * 4);
#pragma unroll
                for (int vi = 0; vi < 2; ++vi) {
                    f32x4 acc = Sacc[vi];
#pragma unroll
                    for (int kk = 0; kk < 2; ++kk)
                        acc = __builtin_amdgcn_mfma_f32_16x16x32_bf16(lds_frag(KBT, wave * 16 + fr, LDT, kk * 32 + fq * 8), lds_frag(VT, vi * 16 + fr, LDT, kk * 32 + fq * 8), acc, 0, 0, 0);
                    acc = acc * el;
                    Sacc[vi] = acc;
                    *(u32x2*)(STn + (vi * 16 + fr) * LDQ + wave * 16 + fq * 4) = pk4(acc);
                }
            }
            LDS_BARRIER();
            cur ^= 1;
        }
#undef GL_FILL
#undef GL_ISSUE
#pragma unroll
        for (int vi = 0; vi < 2; ++vi)
#pragma unroll
            for (int j = 0; j < 4; ++j) P.out[O_GLAP + ((size_t)(b * 4 + hd) * 128 + wave * 16 + fq * 4 + j) * 256 + vs * 32 + vi * 16 + fr] = Sacc[vi][j];
    }
    {
        const float* st_in = P.in(4); const float* wgk = P.in(29); const float* bgk = P.in(30);
        for (int pair = blockIdx.x; pair < NSB * 4; pair += gridDim.x) {
            const int b = pair >> 2, hd = pair & 3;
            const size_t m = (size_t)NPROMPT + b;
            __syncthreads();
            if (tid < 128) {
                float x = bgk[hd * 128 + tid];
#pragma unroll
                for (int i = 0; i < 16; ++i) x += GL[m * 16 + i] * wgk[(size_t)i * 512 + hd * 128 + tid];
                LE[tid] = gk_to_e(x); LK[tid] = (float)Z[m * 3072 + 512 + hd * 128 + tid]; LQ[tid] = (float)Z[m * 3072 + hd * 128 + tid] * 0.08838834764831845f;
            }
            __syncthreads();
            const int v4 = (tid & 63) * 4, kg = tid >> 6;
            const f32x4 vval = f4(*(const h16x4*)(Z + m * 3072 + 1024 + hd * 256 + v4));
            f32x4 o = (f32x4){0.f, 0.f, 0.f, 0.f};
            const size_t sb = ((size_t)(b * 4 + hd) * 128 + kg * 16) * 256 + v4;
#pragma unroll
            for (int hb = 0; hb < 2; ++hb) {
                f32x4 s0[8];
#pragma unroll
                for (int j = 0; j < 8; ++j) s0[j] = *(const f32x4*)(st_in + sb + (size_t)(hb * 8 + j) * 256);
#pragma unroll
                for (int j = 0; j < 8; ++j) {
                    const int k = kg * 16 + hb * 8 + j;
                    const f32x4 sn = s0[j] * LE[k] + vval * LK[k];
                    o += sn * LQ[k];
                    *(f32x4*)(P.out + O_GLAS + sb + (size_t)(hb * 8 + j) * 256) = sn;
                }
            }
            *(f32x4*)(LOP + kg * 256 + v4) = o;
            __syncthreads();
            if (tid < 256) { float r = 0.f;
#pragma unroll
                for (int g = 0; g < 8; ++g) r += LOP[g * 256 + tid];
                O[m * 1024 + hd * 256 + tid] = r; }
        }
    }
}
__device__ __forceinline__ void gla_post(const Ctx& c, const Params& P) {
    const h16* Z = (const h16*)(P.ws + R_BIG + B_Z); const float* O = (const float*)(P.ws + R_BIG + B_O); bf16_t* XN = (bf16_t*)(P.ws + R_XN);
    const f32x4 nw = *(const f32x4*)(P.in(31) + c.lane * 4);
#define GP_LOAD(X, m_) do { _Pragma("unroll") for (int j_ = 0; j_ < 4; ++j_) { const int col_ = c.lane * 4 + 256 * j_; \
        X##o[j_] = *(const f32x4*)(O + (size_t)(m_) * 1024 + col_); X##g[j_] = *(const h16x4*)(Z + (size_t)(m_) * 3072 + 2048 + col_); } } while (0)
    f32x4 co[4], no[4]; h16x4 cg[4], ng[4];
    int m = c.gw;
    if (m < MREAL) GP_LOAD(c, m);
    while (m < MREAL) {
        const int mn = m + c.NGW;
        if (mn < MREAL) GP_LOAD(n, mn);
#pragma unroll
        for (int j = 0; j < 4; ++j) {
            const int col = c.lane * 4 + 256 * j;
            const f32x4 o = co[j], g = f4(cg[j]);
            const float ms = wave_sum((o[0] * o[0] + o[1] * o[1]) + (o[2] * o[2] + o[3] * o[3])) * (1.0f / 256.0f);
            const float rs = 1.0f / sqrtf(ms + 1e-5f);
            f32x4 r;
#pragma unroll
            for (int i = 0; i < 4; ++i) r[i] = o[i] * rs * nw[i] * (g[i] * sigmoidf_(g[i]));
            *(u32x2*)(XN + (size_t)m * 1024 + col) = pk4(r);
        }
#pragma unroll
        for (int j = 0; j < 4; ++j) { co[j] = no[j]; cg[j] = ng[j]; }
        m = mn;
    }
#undef GP_LOAD
}

__device__ __forceinline__ f32x4 conv_zc(const h16* Z, size_t m, int col) { return f4(*(const h16x4*)(Z + m * 3072 + 1024 + col)) * f4(*(const h16x4*)(Z + m * 3072 + 2048 + col)); }
__device__ __forceinline__ void conv_mid(const Ctx& c, const Params& P) {
    const h16* Z = (const h16*)(P.ws + R_BIG + B_Z); bf16_t* XN = (bf16_t*)(P.ws + R_XN);
    const float* cw = P.in(34);
    for (int m = c.gw; m < MP; m += c.NGW) {
        if (m >= MREAL) continue;
#pragma unroll
        for (int j = 0; j < 4; ++j) {
            const int col = c.lane * 4 + 256 * j;
            const f32x4 z0 = conv_zc(Z, m, col);
            f32x4 z1 = (f32x4){0.f, 0.f, 0.f, 0.f}, z2 = z1;
            if (m < NPROMPT) {
                const int t = m & 2047, b = m >> 11;
                if (t >= 1) z1 = conv_zc(Z, m - 1, col);
                if (t >= 2) z2 = conv_zc(Z, m - 2, col);
                if (t >= 2046) *(f32x4*)(P.out + O_CONVP + ((size_t)b * 2 + (t - 2046)) * 1024 + col) = z0;
            } else {
                const int b = m - NPROMPT;
                z2 = *(const f32x4*)(P.in(5) + ((size_t)b * 2 + 0) * 1024 + col);
                z1 = *(const f32x4*)(P.in(5) + ((size_t)b * 2 + 1) * 1024 + col);
                *(f32x4*)(P.out + O_CONVS + ((size_t)b * 2 + 0) * 1024 + col) = z1;
                *(f32x4*)(P.out + O_CONVS + ((size_t)b * 2 + 1) * 1024 + col) = z0;
            }
            const f32x4 cv = *(const f32x4*)(cw + col) * z2 + *(const f32x4*)(cw + 1024 + col) * z1 + *(const f32x4*)(cw + 2048 + col) * z0;
            const f32x4 gB = f4(*(const h16x4*)(Z + (size_t)m * 3072 + col));
            *(u32x2*)(XN + (size_t)m * 1024 + col) = pk4(gB * cv);
        }
    }
}

__device__ __forceinline__ void pool_norm(const Ctx& c, const Params& P) {
    norm_rows<true>(c, P.out, P.in(7) + 3 * 1024, nullptr, (float*)(P.ws + R_BIG));
}
__device__ __forceinline__ void pool_mid(const Ctx& c, const Params& P) {
    const float* U = (const float*)(P.ws + R_BIG); bf16_t* XN = (bf16_t*)(P.ws + R_XN);
    const float* buf = P.in(6);
    for (int m = c.gw; m < MREAL; m += c.NGW) {
        f32x4 u[4], s[4]; float cnt[4];
        if (m < NPROMPT) {
            const int t = m & 2047;
#pragma unroll
            for (int j = 0; j < 4; ++j) {
                const int col = c.lane * 4 + 256 * j, w = 2 << j;
                u[j] = *(const f32x4*)(U + (size_t)m * 1024 + col);
                f32x4 a = u[j];
                if (t + 1 >= w) {
#pragma unroll
                    for (int i = 1; i < w; ++i) a += *(const f32x4*)(U + (size_t)(m - i) * 1024 + col);
                    cnt[j] = (float)w;
                } else {
                    for (int i = 1; i <= t; ++i) a += *(const f32x4*)(U + (size_t)(m - i) * 1024 + col);
                    cnt[j] = (float)(t + 1);
                }
                s[j] = a;
            }
        } else {
            const int b = m - NPROMPT;
#pragma unroll
            for (int j = 0; j < 4; ++j) {
                const int col = c.lane * 4 + 256 * j, w = 2 << j;
                u[j] = *(const f32x4*)(U + (size_t)m * 1024 + col);
                f32x4 a = u[j];
#pragma unroll
                for (int i = 1; i < w; ++i) a += *(const f32x4*)(buf + ((size_t)b * 15 + (15 - i)) * 1024 + col);
                cnt[j] = (float)w; s[j] = a;
            }
        }
#pragma unroll
        for (int j = 0; j < 4; ++j) {
            const int col = c.lane * 4 + 256 * j;
            *(u32x2*)(XN + (size_t)m * 1024 + col) = pk4(s[j] / cnt[j] - u[j]);
            if (m < NPROMPT) { const int t = m & 2047, b = m >> 11;
                if (t >= SEQ - 15) *(f32x4*)(P.out + O_POOLP + ((size_t)b * 15 + (t - (SEQ - 15))) * 1024 + col) = u[j]; }
        }
        if (m >= NPROMPT) {
            const int b = m - NPROMPT;
            for (int i = 0; i < 15; ++i)
#pragma unroll
                for (int j = 0; j < 4; ++j) {
                    const int col = c.lane * 4 + 256 * j;
                    const f32x4 val = (i < 14) ? *(const f32x4*)(buf + ((size_t)b * 15 + i + 1) * 1024 + col) : u[j];
                    *(f32x4*)(P.out + O_POOLS + ((size_t)b * 15 + i) * 1024 + col) = val;
                }
        }
    }
}

#define XB_TMO      128
#define XB_XCNT(j)  (256  + 64 * (j))
#define XB_XSUB(j)  (1280 + 64 * (j))
#define XB_XGEN(j)  (2304 + 64 * (j))
#define XB_TOP      3328
#define XB_TOPGEN   3392
#define XCD_BAR_WORDS 3456
#define XB_SPIN_CAP (1u << 18)
__device__ __forceinline__ unsigned xb_ld(unsigned* p)              { return __hip_atomic_load(p, __ATOMIC_RELAXED, __HIP_MEMORY_SCOPE_AGENT); }
__device__ __forceinline__ unsigned xb_add(unsigned* p, unsigned v) { return __hip_atomic_fetch_add(p, v, __ATOMIC_RELAXED, __HIP_MEMORY_SCOPE_AGENT); }
__device__ __forceinline__ unsigned xb_xcc_id() { return (unsigned)__builtin_amdgcn_s_getreg((3 << 11) | 20) & 0xFu; }
#define XB_SPIN(cond, bar) do { unsigned _sp = 0; while (cond) { __builtin_amdgcn_s_sleep(1); \
    if ((++_sp & 255u) == 0u) { if (xb_ld(&(bar)[XB_TMO])) break; if (_sp > XB_SPIN_CAP) { atomicAdd(&(bar)[XB_TMO], 1u); break; } } } } while (0)
struct XcdBarrier { unsigned* bar; unsigned x; volatile LAS unsigned* st; };
__device__ __forceinline__ void xcd_barrier_complete(unsigned* bar, unsigned x, unsigned& nloc, unsigned& nx) {
    const unsigned G = gridDim.x * gridDim.y * gridDim.z;
    unsigned sum, cnt, mine, sp = 0u;
    for (;;) {
        sum = 0u; cnt = 0u; mine = 0u;
#pragma unroll
        for (unsigned j = 0; j < 16; ++j) { const unsigned c = xb_ld(&bar[XB_XCNT(j)]); sum += c; cnt += (c > 0u) ? 1u : 0u; mine = (j == x) ? c : mine; }
        if (sum == G) break;
        __builtin_amdgcn_s_sleep(1);
        if ((++sp & 255u) == 0u) { if (xb_ld(&bar[XB_TMO])) break; if (sp > XB_SPIN_CAP) { atomicAdd(&bar[XB_TMO], 1u); break; } }
    }
    nloc = mine > 0u ? mine : 1u; nx = cnt > 0u ? cnt : 1u;
}
__device__ __forceinline__ void xcd_barrier(const XcdBarrier& b) {
    asm volatile("s_waitcnt vmcnt(0)" ::: "memory");
    __syncthreads();
    if (threadIdx.x == 0) {
        unsigned* bar = b.bar;
        __builtin_amdgcn_s_waitcnt(0);
        unsigned nloc = b.st[0], nx = b.st[1];
        if (nloc == 0u) { xcd_barrier_complete(bar, b.x, nloc, nx); b.st[0] = nloc; b.st[1] = nx; }
        const unsigned old = xb_add(&bar[XB_XSUB(b.x)], 1u);
        const unsigned gen = old / nloc;
        if (old + 1u == (gen + 1u) * nloc) {
            __builtin_amdgcn_fence(__ATOMIC_RELEASE, "agent");
            asm volatile("s_waitcnt vmcnt(0)" ::: "memory");
            const unsigned og = xb_add(&bar[XB_TOP], 1u);
            const unsigned tg = og / nx;
            if (og + 1u == (tg + 1u) * nx) xb_add(&bar[XB_TOPGEN], 1u);
            else XB_SPIN(xb_ld(&bar[XB_TOPGEN]) == tg, bar);
            __builtin_amdgcn_fence(__ATOMIC_ACQUIRE, "agent");
            xb_add(&bar[XB_XGEN(b.x)], 1u);
            asm volatile("s_waitcnt vmcnt(0)" ::: "memory");
        } else {
            XB_SPIN(xb_ld(&bar[XB_XGEN(b.x)]) == gen, bar);
            __builtin_amdgcn_fence(__ATOMIC_ACQUIRE, "agent");
            asm volatile("s_waitcnt vmcnt(0)" ::: "memory");
        }
    }
    __syncthreads();
}

__global__ void __launch_bounds__(512, 2) hybrid_fwd(Args A) {
    extern __shared__ __attribute__((aligned(16))) unsigned char lds[];
    cg::grid_group grid = cg::this_grid();
    Params P; P.tab = (LAS unsigned long long*)((LAS unsigned char*)lds + LDS_TAB); P.out = A.out; P.ws = A.ws;
    if (threadIdx.x == 0) {
#pragma unroll
        for (int i = 0; i < 38; ++i) P.tab[i] = (unsigned long long)A.in[i];
        P.tab[40] = 0ull;
    }
    if (blockIdx.x == 0) for (int i = threadIdx.x; i < XCD_BAR_WORDS; i += 512) ((unsigned*)(A.ws + WS_BAR))[i] = 0u;
    __syncthreads();

    Ctx c;
    const int wave0 = __builtin_amdgcn_readfirstlane(threadIdx.x >> 6);
#define FRESH() do { int w_ = wave0; unsigned ones_ = ~0u; asm volatile("" : "+s"(w_), "+s"(ones_)); \
        int l_ = (int)__builtin_amdgcn_mbcnt_hi(ones_, __builtin_amdgcn_mbcnt_lo(ones_, 0u)); asm volatile("" : "+v"(l_)); \
        int g_ = gridDim.x, b_ = blockIdx.x; asm volatile("" : "+s"(g_), "+s"(b_)); G = g_; cid = b_; \
        c.lane = l_; c.wave = w_; c.tid = w_ * 64 + l_; c.gw = b_ * 8 + w_; c.NGW = g_ * 8; \
        unsigned long long o_ = (unsigned long long)A.out, s_ = (unsigned long long)A.ws; asm volatile("" : "+s"(o_), "+s"(s_)); \
        P.out = (float*)(__attribute__((address_space(1))) float*)o_; P.ws = (unsigned char*)(__attribute__((address_space(1))) unsigned char*)s_; \
        h = P.out; XN = (bf16_t*)(P.ws + R_XN); } while (0)
#define SYNC0() do { grid.sync(); FRESH(); if (c.tid == 0) (void)xb_add((unsigned*)(P.ws + WS_BAR) + XB_XCNT(xb_xcc_id()), 1u); } while (0)
#define SYNC() do { XcdBarrier xb; xb.bar = (unsigned*)(P.ws + WS_BAR); xb.x = xb_xcc_id(); xb.st = (volatile LAS unsigned*)(P.tab + 40); xcd_barrier(xb); FRESH(); } while (0)
    LAS unsigned char* ldsl = (LAS unsigned char*)lds;
    LAS float* scr = (LAS float*)(ldsl + wave0 * 8448);
    int G, cid;
    float* h; bf16_t* XN;
    constexpr int NOGRP = 31;
    FRESH();

    for (int l = 0; l < 4; ++l) {
        if (l == 0) {
            rwkv_wprep(c, scr, P);
            rwkv_prep(c, P);
            SYNC0();
            { pg8::Gemm g{(const bf16_t*)(P.ws + R_BIG + B_U2), (const bf16_t*)(P.ws + R_W + W_MIX1), 2048, 2048, 2048, NOGRP, 0u};
              pg8::StaticOrder S; S.init(NPROMPT / 256, 15, G, cid);
              pg8::Epi<pg8::EP_RKV> E{(void*)(P.ws + R_BIG + B_RKV), (void*)(P.ws + R_BIG + B_LH), nullptr, nullptr};
              pg8::gemm_phase(c.tid, ldsl, g, S, E); FRESH(); pg8::thin_gemm<pg8::EP_RKV, false>(c.lane, c.wave, g, 3840, 1, E, lds); }
            SYNC();
            { pg8::Gemm g{(const bf16_t*)(P.ws + R_BIG + B_LH), (const bf16_t*)(P.ws + R_W + W_MIX2), 768, 256, 256, 2, 512u};
              pg8::StaticOrder S; S.init(NPROMPT / 256, 12, G, cid);
              pg8::Epi<pg8::EP_LORA2> E{(void*)(P.ws + R_BIG + B_WAG), nullptr, P.in(14), P.in(17)};
              pg8::gemm_phase(c.tid, ldsl, g, S, E); FRESH(); pg8::thin_gemm<pg8::EP_LORA2, false>(c.lane, c.wave, g, 3072, 1, E, lds); }
            SYNC();
            rwkv_scan(c, P, lds);
            SYNC();
            rwkv_post(c, P);
            SYNC();
        } else if (l == 1 || l == 2) {
            int base = 0;
            if (l == 1) {
                wprep(c, scr, base, P.in(28), 1024, 3088, 3088, (bf16_t*)(P.ws + R_W + W_MIX1), 1024, 3328, 1024, 0, 0, nullptr, 0);
                wprep(c, scr, base, P.in(32), 1024, 1024, 1024, (bf16_t*)(P.ws + R_W + W_WO), 1024, 1024, 1024, 0, 0, nullptr, 0);
            } else {
                wprep(c, scr, base, P.in(33), 1024, 3072, 3072, (bf16_t*)(P.ws + R_W + W_MIX1), 1024, 3072, 1024, 0, 0, nullptr, 0);
                wprep(c, scr, base, P.in(35), 1024, 1024, 1024, (bf16_t*)(P.ws + R_W + W_WO), 1024, 1024, 1024, 0, 0, nullptr, 0);
            }
            wprep_ffn(c, scr, base, P, l);
            norm_to_xn(c, h, P.in(7) + l * 1024, XN);
            SYNC();
            { pg8::Gemm g{XN, (const bf16_t*)(P.ws + R_W + W_MIX1), 1024, 1024, 1024, NOGRP, 0u};
              pg8::StaticOrder S; S.init(NPROMPT / 256, 12, G, cid);
              if (l == 1) pg8::gl_direct(c.lane, c.gw, c.NGW, XN, g.Bt, (float*)(P.ws + R_BIG + B_GL));
              pg8::Epi<pg8::EP_Z> E{(void*)(P.ws + R_BIG + B_Z), (void*)(P.ws + R_BIG + B_GL), nullptr, nullptr};
              pg8::gemm_phase(c.tid, ldsl, g, S, E); FRESH(); pg8::thin_gemm<pg8::EP_Z, false>(c.lane, c.wave, g, l == 1 ? 3328 : 3072, 1, E, lds); }
            SYNC();
            if (l == 1) { gla_pre(c, P, lds); SYNC(); gla_scan(c, P, lds); SYNC(); gla_post(c, P); }
            else conv_mid(c, P);
            SYNC();
        } else {
            int base = 0;
            for (int gi = 0; gi < 4; ++gi)
                wprep(c, scr, base, P.in(36) + gi * 65536, 256, 256, 256, (bf16_t*)(P.ws + R_W + W_MIX1), 256, 256, 256, gi * 256, 0, P.in(37) + gi * 256, 3);
            wprep_ffn(c, scr, base, P, 3);
            pool_norm(c, P);
            SYNC();
            pool_mid(c, P);
            SYNC();
        }
        { pg8::Gemm g = (l == 3) ? pg8::Gemm{XN, (const bf16_t*)(P.ws + R_W + W_MIX1), 1024, 256, 256, 0, 512u}
                                 : pg8::Gemm{XN, (const bf16_t*)(P.ws + R_W + W_WO), 1024, 1024, 1024, NOGRP, 0u};
          pg8::StaticOrder S; S.init(NPROMPT / 256, 4, G, cid);
          pg8::Epi<pg8::EP_RESI> E{(void*)h, nullptr, (l == 0) ? P.in(0) : nullptr, nullptr};
          pg8::gemm_phase(c.tid, ldsl, g, S, E); FRESH(); pg8::thin_gemm<pg8::EP_RESI, true>(c.lane, c.wave, g, 1024, (l == 3) ? 1 : 4, E, lds); }
        SYNC();
        norm_to_xn(c, h, P.in(8) + l * 1024, XN);
        SYNC();
        { pg8::Gemm g{XN, (const bf16_t*)(P.ws + R_W + W_UP), 1024, 1024, 1024, NOGRP, 0u};
          pg8::StaticOrder S; S.init(NPROMPT / 256, 16, G, cid);
          pg8::Epi<pg8::EP_UP> E{(void*)(P.ws + R_BIG), nullptr, nullptr, nullptr};
          pg8::gemm_phase(c.tid, ldsl, g, S, E); FRESH(); pg8::thin_gemm<pg8::EP_UP, false>(c.lane, c.wave, g, 4096, 1, E, lds); }
        SYNC();
        { pg8::Gemm g{(const bf16_t*)(P.ws + R_BIG), (const bf16_t*)(P.ws + R_W + W_DOWN), 4096, 4096, 4096, NOGRP, 0u};
          pg8::StaticOrder S; S.init(NPROMPT / 256, 4, G, cid);
          pg8::Epi<pg8::EP_RESI> E{(void*)h, nullptr, nullptr, nullptr};
          pg8::gemm_phase(c.tid, ldsl, g, S, E); FRESH(); pg8::thin_gemm<pg8::EP_RESI, true>(c.lane, c.wave, g, 1024, 4, E, lds); }
        SYNC();
    }
    norm_rows<true>(c, h, P.in(9), nullptr, h);
}

extern "C" void kernel_launch(void* const* d_in, const int* in_sizes, int n_in, void* d_out, int out_size, void* d_ws, size_t ws_size, hipStream_t stream) {
    static int grid = 0;
    if (grid == 0) {
        if (n_in != 38 || ws_size < WS_NEED) { fprintf(stderr, "kernel_launch: need 38 inputs and %zu bytes of workspace; got %d, %zu\n", (size_t)WS_NEED, n_in, ws_size); grid = -1; return; }
        int dev = 0, cus = 0, per_cu = 0;
        (void)hipGetDevice(&dev);
        (void)hipDeviceGetAttribute(&cus, hipDeviceAttributeMultiprocessorCount, dev);
        if (hipFuncSetAttribute((const void*)hybrid_fwd, hipFuncAttributeMaxDynamicSharedMemorySize, LDS_BYTES) != hipSuccess) { fprintf(stderr, "kernel_launch: hipFuncSetAttribute failed\n"); grid = -1; return; }
        if (hipOccupancyMaxActiveBlocksPerMultiprocessor(&per_cu, (const void*)hybrid_fwd, 512, LDS_BYTES) != hipSuccess || per_cu < 1) { fprintf(stderr, "kernel_launch: occupancy query failed (%d)\n", per_cu); grid = -1; return; }
        grid = cus;
    }
    if (grid < 0) return;
    Args p{};
    for (int i = 0; i < 38; ++i) p.in[i] = (const float*)d_in[i];
    p.out = (float*)d_out; p.ws = (unsigned char*)d_ws;
    void* args[] = {&p};
    hipError_t e = hipLaunchCooperativeKernel((const void*)hybrid_fwd, dim3(grid), dim3(512), args, LDS_BYTES, stream);
    if (e != hipSuccess) fprintf(stderr, "cooperative launch failed: %s (grid %d)\n", hipGetErrorString(e), grid);
}
```

```cpp
#include <hip/hip_runtime.h>
#include <hip/hip_cooperative_groups.h>
#include <cstdio>
#include <cstdint>
namespace cg = cooperative_groups;

#define LAS __attribute__((address_space(3)))
typedef unsigned short bf16_t;
typedef _Float16 h16;
typedef short bf16x8 __attribute__((ext_vector_type(8)));
typedef float f32x4 __attribute__((ext_vector_type(4)));
typedef float f32x2 __attribute__((ext_vector_type(2)));
typedef unsigned u32x4 __attribute__((ext_vector_type(4)));
typedef unsigned u32x2 __attribute__((ext_vector_type(2)));
typedef _Float16 h16x2 __attribute__((ext_vector_type(2)));
typedef _Float16 h16x4 __attribute__((ext_vector_type(4)));
typedef _Float16 h16x8 __attribute__((ext_vector_type(8)));

constexpr int D = 1024, NPROMPT = 16384, SEQ = 2048, NB = 8, NSB = 128, MREAL = 16512, MP = 16640, DFF = 4096;
constexpr size_t O_Y = 0, O_WKVP = 16908288, O_WKVS = 17432576, O_SHP = 25821184, O_SHS = 25829376, O_GLAP = 25960448, O_GLAS = 27009024,
                 O_CONVP = 43786240, O_CONVS = 43802624, O_POOLP = 44064768, O_POOLS = 44187648;
constexpr size_t W_MIX1 = 0, W_MIX2 = 15728640, W_WO = 17301504, W_UP = 19398656, W_DOWN = 27787264, W_END = 36175872;
constexpr size_t R_W = 0, R_XN = 36700160, R_BIG = R_XN + (size_t)MP * 1024 * 2;
constexpr size_t B_WAG = 0, B_U2 = 0, B_RKV = (size_t)MP * 3072 * 2, B_LH = B_RKV + (size_t)MP * 3072 * 2, B_Y = B_LH + (size_t)MP * 768 * 2, B_END0 = B_Y + (size_t)MP * 1024 * 2;
constexpr size_t B_Z = 0, B_GL = (size_t)MP * 3072 * 2, B_O = B_GL + (size_t)MP * 16 * 4;
constexpr size_t WS_BAR = R_BIG + B_END0;
constexpr size_t WS_NEED = WS_BAR + 16384;
constexpr int LDS_TAB = 155648, LDS_BYTES = 155648 + 512;

struct Args { const float* in[38]; float* out; unsigned char* ws; };
struct Params {
    LAS unsigned long long* tab; float* out; unsigned char* ws;
    __device__ __forceinline__ const float* in(int i) const { const unsigned long long v = tab[i];
        const unsigned lo = __builtin_amdgcn_readfirstlane((unsigned)v), hi = __builtin_amdgcn_readfirstlane((unsigned)(v >> 32));
        return (const float*)(const __attribute__((address_space(1))) float*)(((unsigned long long)hi << 32) | lo); }
};

__device__ __forceinline__ unsigned f2bf(float f) { unsigned u = __builtin_bit_cast(unsigned, f); return (u + 0x7fffu + ((u >> 16) & 1u)) >> 16; }
__device__ __forceinline__ unsigned pk2(float lo, float hi) { return f2bf(lo) | (f2bf(hi) << 16); }
__device__ __forceinline__ u32x2 pk4(f32x4 v) { u32x2 r; r.x = pk2(v[0], v[1]); r.y = pk2(v[2], v[3]); return r; }
__device__ __forceinline__ h16x4 h4(f32x4 v) { h16x4 r; r[0] = (h16)v[0]; r[1] = (h16)v[1]; r[2] = (h16)v[2]; r[3] = (h16)v[3]; return r; }
__device__ __forceinline__ f32x4 f4(h16x4 v) { f32x4 r; r[0] = (float)v[0]; r[1] = (float)v[1]; r[2] = (float)v[2]; r[3] = (float)v[3]; return r; }
template <int CTRL> __device__ __forceinline__ float dppmov(float v) { return __builtin_bit_cast(float, __builtin_amdgcn_update_dpp(0, __builtin_bit_cast(int, v), CTRL, 0xF, 0xF, true)); }
__device__ __forceinline__ float reduce16(float v) {
    v += dppmov<0xB1>(v);
    v += dppmov<0x4E>(v);
    v += dppmov<0x141>(v);
    v += dppmov<0x140>(v);
    return v;
}
__device__ __forceinline__ float wave_sum(float v) {
    v = reduce16(v);
    const int iv = __builtin_bit_cast(int, v);
    const float r0 = __builtin_bit_cast(float, __builtin_amdgcn_readlane(iv, 0)), r1 = __builtin_bit_cast(float, __builtin_amdgcn_readlane(iv, 16));
    const float r2 = __builtin_bit_cast(float, __builtin_amdgcn_readlane(iv, 32)), r3 = __builtin_bit_cast(float, __builtin_amdgcn_readlane(iv, 48));
    return (r0 + r1) + (r2 + r3);
}
__device__ __forceinline__ float fexp(float x) { return __builtin_amdgcn_exp2f(x * 1.4426950408889634f); }
__device__ __forceinline__ float flog(float x) { return __builtin_amdgcn_logf(x) * 0.6931471805599453f; }
__device__ __forceinline__ float sigmoidf_(float x) { return __builtin_amdgcn_rcpf(1.0f + fexp(-x)); }
__device__ __forceinline__ float softplusf_(float x) { return fmaxf(x, 0.f) + flog(1.0f + fexp(-fabsf(x))); }
__device__ __forceinline__ float tanhf_(float x) { return 1.0f - 2.0f * __builtin_amdgcn_rcpf(1.0f + fexp(2.0f * x)); }
#define LDS_WAIT() asm volatile("s_waitcnt lgkmcnt(0)" ::: "memory")
#define LDS_BARRIER() do { asm volatile("s_waitcnt lgkmcnt(0)" ::: "memory"); __builtin_amdgcn_s_barrier(); asm volatile("" ::: "memory"); } while (0)

namespace pg8 {
constexpr int BM = 256, BK = 64, HALF = 128, HTB = HALF * BK * 2, STAGE_BYTES = 8 * HTB, NXCD = 8, WGM = 8;
__host__ __device__ __forceinline__ int lds_byte(int r, int c) { const int st = (r >> 4) * 2 + (c >> 5), rr = r & 15, cc = c & 31, ob = rr * 64 + cc * 2; return st * 1024 + (ob ^ (((ob >> 9) & 1) << 5)); }
__host__ __device__ __forceinline__ void stage_rc(int b, int& R, int& C) { const int st = b / 1024, sb = b % 1024, swz = sb ^ (((sb >> 9) & 1) << 5); R = (st >> 1) * 16 + swz / 64; C = (st & 1) * 32 + (swz % 64) / 2; }
__host__ __device__ __forceinline__ int perm32(int rho) { const int n = rho >> 4, i = rho & 15; return 8 * (i >> 2) + 4 * n + (i & 3); }

__device__ __forceinline__ const char* sgpr_ptr(const char* p) { const unsigned long long v = (unsigned long long)p;
    const unsigned lo = __builtin_amdgcn_readfirstlane((unsigned)v), hi = __builtin_amdgcn_readfirstlane((unsigned)(v >> 32));
    return (const char*)(const __attribute__((address_space(1))) char*)(((unsigned long long)hi << 32) | lo); }
struct Unit { int pm, pn; };
struct Gemm { const bf16_t* A; const bf16_t* Bt; int lda, ldb, K, grp_shift; unsigned a_grp_bytes; };
__device__ __forceinline__ const char* unit_a(const Gemm& g, const Unit& u) { return (const char*)g.A + (size_t)(u.pn >> g.grp_shift) * g.a_grp_bytes + (size_t)u.pm * (size_t)(BM * 2) * (size_t)g.lda; }
__device__ __forceinline__ const char* unit_b(const Gemm& g, const Unit& u) { return (const char*)g.Bt + (size_t)u.pn * (size_t)(BM * 2) * (size_t)g.ldb; }

struct StaticOrder {
    int nM, nN, nwg, G, c;
    __device__ void init(int nM_, int nN_, int G_, int c_) { nM = nM_; nN = nN_; nwg = nM * nN; G = G_; c = c_; }
    __device__ bool next(int i, Unit& u) const {
        const long L = (long)i * G + c; if (L >= nwg) return false;
        int wgid = (int)L; { const int q = nwg / NXCD, r = nwg % NXCD, xcd = wgid % NXCD, off = wgid / NXCD; wgid = (xcd < r ? xcd * (q + 1) : r * (q + 1) + (xcd - r) * q) + off; }
        const int nig = WGM * nN, gid = wgid / nig, fm = gid * WGM, gsz = (nM - fm) < WGM ? (nM - fm) : WGM;
        u.pm = __builtin_amdgcn_readfirstlane(fm + ((wgid % nig) % gsz)); u.pn = __builtin_amdgcn_readfirstlane((wgid % nig) / gsz); return true;
    }
};

template <class Epi>
__device__ __forceinline__ void gemm_phase(const int tid, LAS unsigned char* lds, const Gemm g, const StaticOrder& S, const Epi& E) {
    const int wid = __builtin_amdgcn_readfirstlane(tid >> 6), lane = tid & 63, wr = wid >> 2, wc = wid & 3, fr = lane & 15, fq = lane >> 4;
    const int K = g.K, nt = K / BK;
    unsigned voffA[2], voffB[2];
#pragma unroll
    for (int i = 0; i < 2; ++i) { int R, C; stage_rc(tid * 16 + i * 8192, R, C); const int Rb = Epi::PERM ? ((R & ~31) + perm32(R & 31)) : R;
        voffA[i] = (unsigned)(R * g.lda + C) * 2u; voffB[i] = (unsigned)(Rb * g.ldb + C) * 2u; }
    const size_t kstep = (size_t)(BK * 2);
    const size_t hstepA = (size_t)HALF * g.lda * 2, hstepB = (size_t)HALF * g.ldb * 2;
    const unsigned ldsw = (unsigned)wid * 1024u;
    const int aoff = lds_byte(wr * 64 + fr, fq * 8), boff = lds_byte(wc * 32 + fr, fq * 8);
#define PG8_SA(b, h) (((b) * 2 + (h)) * HTB)
#define PG8_SB(b, h) ((4 + (b) * 2 + (h)) * HTB)
#define PG8_STAGE(bufoff, gbase, voff) do { const char* gb_ = sgpr_ptr(gbase); _Pragma("unroll") for (int _i = 0; _i < 2; ++_i) \
        __builtin_amdgcn_global_load_lds((const unsigned*)(gb_ + (voff)[_i]), (LAS unsigned*)(lds + (bufoff) + ldsw + _i * 8192), 16, 0, 0); } while (0)
#define PG8_LDA(dst, b, h) do { _Pragma("unroll") for (int m = 0; m < 4; ++m) _Pragma("unroll") for (int k = 0; k < 2; ++k) dst[m][k] = *(const LAS bf16x8*)(lds + PG8_SA(b, h) + aoff + m * 2048 + k * 1024); } while (0)
#define PG8_LDB(dst, b, h) do { _Pragma("unroll") for (int n = 0; n < 2; ++n) _Pragma("unroll") for (int k = 0; k < 2; ++k) dst[n][k] = *(const LAS bf16x8*)(lds + PG8_SB(b, h) + boff + n * 2048 + k * 1024); } while (0)
#define PG8_MMA(ai, bj, At, Bt) do { __builtin_amdgcn_s_setprio(1); _Pragma("unroll") for (int m = 0; m < 4; ++m) _Pragma("unroll") for (int n = 0; n < 2; ++n) _Pragma("unroll") for (int k = 0; k < 2; ++k) \
        acc[ai][bj][m][n] = __builtin_amdgcn_mfma_f32_16x16x32_bf16(Bt[n][k], At[m][k], acc[ai][bj][m][n], 0, 0, 0); __builtin_amdgcn_s_setprio(0); } while (0)
#define PG8_WAIT_V(n) asm volatile("s_waitcnt vmcnt(" #n ")" ::: "memory")
#define PG8_WAIT_L(n) asm volatile("s_waitcnt lgkmcnt(" #n ")" ::: "memory")
#define PG8_BAR __builtin_amdgcn_s_barrier()
#define PG8_SCHED __builtin_amdgcn_sched_barrier(0)
    Unit cur, nxt; int ui = 0;
    if (!S.next(0, cur)) return;
    f32x4 acc[2][2][4][2];
    if constexpr (Epi::INIT) E.init(acc, cur, wr, wc, fr, fq);
    else {
#pragma unroll
    for (int a = 0; a < 2; ++a)
#pragma unroll
        for (int b = 0; b < 2; ++b)
#pragma unroll
            for (int m = 0; m < 4; ++m)
#pragma unroll
                for (int n = 0; n < 2; ++n) acc[a][b][m][n] = (f32x4){0.f, 0.f, 0.f, 0.f};
    }
    bf16x8 At[4][2], B0[2][2], B1[2][2];
    const char* cA = unit_a(g, cur); const char* cB = unit_b(g, cur);
    PG8_STAGE(PG8_SB(0, 0), cB, voffB); PG8_STAGE(PG8_SB(0, 1), cB + hstepB, voffB); PG8_STAGE(PG8_SA(0, 0), cA, voffA); PG8_STAGE(PG8_SA(0, 1), cA + hstepA, voffA);
    if (wr == 1) PG8_BAR;
    PG8_WAIT_V(2); PG8_BAR;
    PG8_STAGE(PG8_SB(1, 0), cB + kstep, voffB); PG8_STAGE(PG8_SA(1, 0), cA + kstep, voffA); PG8_STAGE(PG8_SB(1, 1), cB + hstepB + kstep, voffB);
    PG8_WAIT_V(6); PG8_BAR;
    for (;;) {
        const bool has_next = S.next(ui + 1, nxt);
        const char* nA = has_next ? unit_a(g, nxt) : cA; const char* nB = has_next ? unit_b(g, nxt) : cB;
        for (int t = 0; t < nt; t += 2) {
            const bool last = (t == nt - 2);
            const char* a1 = cA + (size_t)(t + 1) * kstep;
            const char* a2 = last ? nA : cA + (size_t)(t + 2) * kstep; const char* b2 = last ? nB : cB + (size_t)(t + 2) * kstep;
            const char* a3 = a2 + kstep; const char* b3 = b2 + kstep;
            PG8_LDB(B0, 0, 0); PG8_LDB(B1, 0, 1); PG8_SCHED; PG8_LDA(At, 0, 0); PG8_STAGE(PG8_SA(1, 1), a1 + hstepA, voffA);
            PG8_WAIT_V(8); PG8_WAIT_L(0); PG8_BAR; PG8_MMA(0, 0, At, B0); PG8_MMA(0, 1, At, B1); PG8_BAR; PG8_SCHED;
            PG8_LDA(At, 0, 1); PG8_STAGE(PG8_SB(0, 0), b2, voffB); PG8_STAGE(PG8_SB(0, 1), b2 + hstepB, voffB); PG8_STAGE(PG8_SA(0, 0), a2, voffA);
            PG8_WAIT_V(8); PG8_WAIT_L(0); PG8_BAR; PG8_MMA(1, 0, At, B0); PG8_MMA(1, 1, At, B1); PG8_BAR; PG8_SCHED;
            PG8_LDB(B0, 1, 0); PG8_LDB(B1, 1, 1); PG8_SCHED; PG8_LDA(At, 1, 0); PG8_STAGE(PG8_SA(0, 1), a2 + hstepA, voffA);
            PG8_WAIT_V(8); PG8_WAIT_L(0); PG8_BAR; PG8_MMA(0, 0, At, B0); PG8_MMA(0, 1, At, B1); PG8_BAR; PG8_SCHED;
            PG8_LDA(At, 1, 1); PG8_STAGE(PG8_SB(1, 0), b3, voffB); PG8_STAGE(PG8_SB(1, 1), b3 + hstepB, voffB); PG8_STAGE(PG8_SA(1, 0), a3, voffA);
            PG8_WAIT_V(8); PG8_WAIT_L(0); PG8_BAR; PG8_MMA(1, 0, At, B0); PG8_MMA(1, 1, At, B1); PG8_BAR; PG8_SCHED;
        }
        if (wr == 0) PG8_BAR;
        E(acc, cur, wr, wc, fr, fq);
        if (!has_next) break;
        if constexpr (Epi::INIT) E.init(acc, nxt, wr, wc, fr, fq);
        else {
#pragma unroll
        for (int a = 0; a < 2; ++a)
#pragma unroll
            for (int b = 0; b < 2; ++b)
#pragma unroll
                for (int m = 0; m < 4; ++m)
#pragma unroll
                    for (int n = 0; n < 2; ++n) acc[a][b][m][n] = (f32x4){0.f, 0.f, 0.f, 0.f};
        }
        cur = nxt; cA = nA; cB = nB; ++ui;
        if (wr == 1) PG8_BAR;
    }
    PG8_WAIT_V(0);
    PG8_BAR;
#undef PG8_SA
#undef PG8_SB
#undef PG8_STAGE
#undef PG8_LDA
#undef PG8_LDB
#undef PG8_MMA
#undef PG8_WAIT_V
#undef PG8_WAIT_L
#undef PG8_BAR
#undef PG8_SCHED
}

enum { EP_RKV = 0, EP_LORA2 = 1, EP_RES = 2, EP_UP = 3, EP_Z = 4, EP_RESI = 5 };
template <int MODE> struct Epi {
    static constexpr bool PERM = (MODE != EP_RES && MODE != EP_RESI), INIT = (MODE == EP_RESI);
    void* o0; void* o1; const float* p0; const float* p1;
    template <bool ATOMIC> __device__ __forceinline__ void put(int row, int col, f32x4 v) const {
        const int pn = col >> 8;
        if constexpr (MODE == EP_RKV) {
            if (pn < 12) { *(h16x4*)((h16*)o0 + (size_t)row * 3072 + col) = h4(v); }
            else {
                if (pn == 12) { v[0] = tanhf_(v[0]); v[1] = tanhf_(v[1]); v[2] = tanhf_(v[2]); v[3] = tanhf_(v[3]); }
                else if (pn == 14) { v[0] = sigmoidf_(v[0]); v[1] = sigmoidf_(v[1]); v[2] = sigmoidf_(v[2]); v[3] = sigmoidf_(v[3]); }
                *(u32x2*)((bf16_t*)o1 + (size_t)row * 768 + (col - 3072)) = pk4(v);
            }
        } else if constexpr (MODE == EP_LORA2) {
            const int grp = pn >> 2, c1 = col & 1023;
            if (grp == 0) { const f32x4 b = *(const f32x4*)(p0 + c1);
#pragma unroll
                for (int j = 0; j < 4; ++j) { const float x = b[j] + v[j]; const float wl = -softplusf_(-x) - 0.5f; v[j] = -fexp(wl); } }
            else if (grp == 1) { const f32x4 b = *(const f32x4*)(p1 + c1);
#pragma unroll
                for (int j = 0; j < 4; ++j) v[j] = sigmoidf_(b[j] + v[j]); }
            *(h16x4*)((h16*)o0 + (size_t)row * 3072 + col) = h4(v);
        } else if constexpr (MODE == EP_RES || MODE == EP_RESI) {
            float* hp = (float*)o0 + (size_t)row * 1024 + col;
            if constexpr (MODE == EP_RES) { if (p0) v = v * *(const f32x4*)(p0 + col); }
            if constexpr (ATOMIC) {
#pragma unroll
                for (int j = 0; j < 4; ++j) (void)__hip_atomic_fetch_add(hp + j, v[j], __ATOMIC_RELAXED, __HIP_MEMORY_SCOPE_AGENT);
            } else *(f32x4*)hp = *(const f32x4*)hp + v;
        } else if constexpr (MODE == EP_UP) {
#pragma unroll
            for (int j = 0; j < 4; ++j) { const float r = fmaxf(v[j], 0.f); v[j] = r * r; }
            *(u32x2*)((bf16_t*)o0 + (size_t)row * 4096 + col) = pk4(v);
        } else {
            if (pn < 12) { *(h16x4*)((h16*)o0 + (size_t)row * 3072 + col) = h4(v); }
            else { const int c = col - 3072; if (c < 16) *(f32x4*)((float*)o1 + (size_t)row * 16 + c) = v; }
        }
    }
    __device__ __forceinline__ void init(f32x4 (&acc)[2][2][4][2], const Unit& u, int wr, int wc, int fr, int fq) const {
        const int rowb = u.pm * BM + wr * 64 + fr, colb = u.pn * BM + wc * 32 + 4 * fq;
#pragma unroll
        for (int ai = 0; ai < 2; ++ai)
#pragma unroll
            for (int m = 0; m < 4; ++m) {
                const float* hrow = (p0 ? p0 : (const float*)o0) + (size_t)(rowb + ai * HALF + m * 16) * 1024 + colb;
#pragma unroll
                for (int bj = 0; bj < 2; ++bj)
#pragma unroll
                    for (int n = 0; n < 2; ++n) acc[ai][bj][m][n] = *(const f32x4*)(hrow + bj * HALF + 16 * n);
            }
    }
    __device__ __forceinline__ void operator()(const f32x4 (&acc)[2][2][4][2], const Unit& u, int wr, int wc, int fr, int fq) const {
        { unsigned ones_ = ~0u; asm volatile("" : "+s"(ones_));
          const int l_ = (int)__builtin_amdgcn_mbcnt_hi(ones_, __builtin_amdgcn_mbcnt_lo(ones_, 0u)); fr = l_ & 15; fq = l_ >> 4; }
        const int rowb = u.pm * BM + wr * 64 + fr;
        const int colb = u.pn * BM + wc * 32 + (PERM ? 8 * fq : 4 * fq);
        if constexpr (MODE == EP_RESI) {
#pragma unroll
            for (int ai = 0; ai < 2; ++ai)
#pragma unroll
                for (int m = 0; m < 4; ++m) {
                    float* hrow = (float*)o0 + (size_t)(rowb + ai * HALF + m * 16) * 1024 + colb;
#pragma unroll
                    for (int bj = 0; bj < 2; ++bj)
#pragma unroll
                        for (int n = 0; n < 2; ++n) *(f32x4*)(hrow + bj * HALF + 16 * n) = acc[ai][bj][m][n];
                }
        } else if constexpr (MODE == EP_RES) {
            f32x4 sc[2][2];
#pragma unroll
            for (int bj = 0; bj < 2; ++bj)
#pragma unroll
                for (int n = 0; n < 2; ++n) sc[bj][n] = p0 ? *(const f32x4*)(p0 + colb + bj * HALF + 16 * n) : (f32x4){1.f, 1.f, 1.f, 1.f};
#pragma unroll
            for (int ai = 0; ai < 2; ++ai)
#pragma unroll
                for (int m = 0; m < 4; ++m) {
                    float* hrow = (float*)o0 + (size_t)(rowb + ai * HALF + m * 16) * 1024 + colb;
                    f32x4 hv[2][2];
#pragma unroll
                    for (int bj = 0; bj < 2; ++bj)
#pragma unroll
                        for (int n = 0; n < 2; ++n) hv[bj][n] = *(const f32x4*)(hrow + bj * HALF + 16 * n);
#pragma unroll
                    for (int bj = 0; bj < 2; ++bj)
#pragma unroll
                        for (int n = 0; n < 2; ++n) *(f32x4*)(hrow + bj * HALF + 16 * n) = hv[bj][n] + acc[ai][bj][m][n] * sc[bj][n];
                }
        } else if constexpr (MODE == EP_LORA2) {
            const int grp = u.pn >> 2;
            const float* bp = (grp == 0) ? p0 : p1;
#pragma unroll
            for (int ai = 0; ai < 2; ++ai)
#pragma unroll
                for (int m = 0; m < 4; ++m) {
                    const int row = rowb + ai * HALF + m * 16;
                    f32x4 bias[2][2];
#pragma unroll
                    for (int bj = 0; bj < 2; ++bj)
#pragma unroll
                        for (int n = 0; n < 2; ++n) bias[bj][n] = (grp < 2) ? *(const f32x4*)(bp + ((colb + bj * HALF + 4 * n) & 1023)) : (f32x4){0.f, 0.f, 0.f, 0.f};
#pragma unroll
                    for (int bj = 0; bj < 2; ++bj)
#pragma unroll
                        for (int n = 0; n < 2; ++n) {
                            f32x4 v = acc[ai][bj][m][n] + bias[bj][n];
                            if (grp == 0) {
#pragma unroll
                                for (int j = 0; j < 4; ++j) { const float wl = -softplusf_(-v[j]) - 0.5f; v[j] = -fexp(wl); } }
                            else if (grp == 1) {
#pragma unroll
                                for (int j = 0; j < 4; ++j) v[j] = sigmoidf_(v[j]); }
                            *(h16x4*)((h16*)o0 + (size_t)row * 3072 + colb + bj * HALF + 4 * n) = h4(v);
                        }
                }
        } else if constexpr (MODE == EP_UP) {
#pragma unroll
            for (int ai = 0; ai < 2; ++ai)
#pragma unroll
                for (int m = 0; m < 4; ++m) {
                    bf16_t* orow = (bf16_t*)o0 + (size_t)(rowb + ai * HALF + m * 16) * 4096 + colb;
#pragma unroll
                    for (int bj = 0; bj < 2; ++bj) {
                        f32x4 v0 = acc[ai][bj][m][0], v1 = acc[ai][bj][m][1];
#pragma unroll
                        for (int j = 0; j < 4; ++j) { const float r0 = fmaxf(v0[j], 0.f), r1 = fmaxf(v1[j], 0.f); v0[j] = r0 * r0; v1[j] = r1 * r1; }
                        *(u32x4*)(orow + bj * HALF) = (u32x4){pk2(v0[0], v0[1]), pk2(v0[2], v0[3]), pk2(v1[0], v1[1]), pk2(v1[2], v1[3])};
                    }
                }
        } else if constexpr (MODE == EP_Z || MODE == EP_RKV) {
            if (u.pn < 12) {
#pragma unroll
                for (int ai = 0; ai < 2; ++ai)
#pragma unroll
                    for (int m = 0; m < 4; ++m) {
                        h16* orow = (h16*)o0 + (size_t)(rowb + ai * HALF + m * 16) * 3072 + colb;
#pragma unroll
                        for (int bj = 0; bj < 2; ++bj) {
                            const f32x4 v0 = acc[ai][bj][m][0], v1 = acc[ai][bj][m][1];
                            h16x8 o; o[0] = (h16)v0[0]; o[1] = (h16)v0[1]; o[2] = (h16)v0[2]; o[3] = (h16)v0[3]; o[4] = (h16)v1[0]; o[5] = (h16)v1[1]; o[6] = (h16)v1[2]; o[7] = (h16)v1[3];
                            *(h16x8*)(orow + bj * HALF) = o;
                        }
                    }
            } else {
#pragma unroll
                for (int ai = 0; ai < 2; ++ai)
#pragma unroll
                    for (int m = 0; m < 4; ++m) {
                        const int row = rowb + ai * HALF + m * 16;
#pragma unroll
                        for (int bj = 0; bj < 2; ++bj)
#pragma unroll
                            for (int n = 0; n < 2; ++n) put<false>(row, colb + bj * HALF + 4 * n, acc[ai][bj][m][n]);
                    }
            }
        } else {
#pragma unroll
            for (int ai = 0; ai < 2; ++ai)
#pragma unroll
                for (int m = 0; m < 4; ++m) {
                    const int row = rowb + ai * HALF + m * 16;
#pragma unroll
                    for (int bj = 0; bj < 2; ++bj)
#pragma unroll
                        for (int n = 0; n < 2; ++n) put<false>(row, colb + bj * HALF + (PERM ? 4 * n : 16 * n), acc[ai][bj][m][n]);
                }
        }
    }
};
template <int MODE, bool ATOMIC>
__device__ __forceinline__ void thin_gemm(int lane, int wave, const Gemm g, int N, int ksplit, const Epi<MODE>& E, unsigned char* ldsb) {
    const int ntn = N >> 4, ntasks = ntn * ksplit, kl = g.K / ksplit, kw = kl >> 3, ns = kw >> 5;
    const int fr = lane & 15, fq = lane >> 4;
    f32x4* red = (f32x4*)ldsb;
    for (int task = blockIdx.x; task < ntasks; task += gridDim.x) {
        const int nt = task % ntn, ks = task / ntn, n0 = nt * 16, k0 = ks * kl + wave * kw;
        const bf16_t* ap = (const bf16_t*)((const char*)g.A + (size_t)((n0 >> 8) >> g.grp_shift) * g.a_grp_bytes) + (size_t)(NPROMPT + fr) * g.lda + k0 + fq * 8;
        const bf16_t* bp = g.Bt + (size_t)(n0 + fr) * g.ldb + k0 + fq * 8;
        const size_t tstride = (size_t)16 * g.lda;
        f32x4 acc[8];
#pragma unroll
        for (int mt = 0; mt < 8; ++mt) acc[mt] = (f32x4){0.f, 0.f, 0.f, 0.f};
        for (int s = 0; s < ns; s += 2) {
            const bool two = (s + 1 < ns);
            bf16x8 b0, b1, a0[8], a1[8];
            b0 = *(const bf16x8*)(bp + 32 * s);
#pragma unroll
            for (int mt = 0; mt < 8; ++mt) a0[mt] = *(const bf16x8*)(ap + mt * tstride + 32 * s);
            if (two) { b1 = *(const bf16x8*)(bp + 32 * s + 32);
#pragma unroll
                for (int mt = 0; mt < 8; ++mt) a1[mt] = *(const bf16x8*)(ap + mt * tstride + 32 * s + 32); }
#pragma unroll
            for (int mt = 0; mt < 8; ++mt) acc[mt] = __builtin_amdgcn_mfma_f32_16x16x32_bf16(b0, a0[mt], acc[mt], 0, 0, 0);
            if (two) {
#pragma unroll
                for (int mt = 0; mt < 8; ++mt) acc[mt] = __builtin_amdgcn_mfma_f32_16x16x32_bf16(b1, a1[mt], acc[mt], 0, 0, 0); }
        }
        __syncthreads();
#pragma unroll
        for (int mt = 0; mt < 8; ++mt) red[(wave * 8 + mt) * 64 + lane] = acc[mt];
        __syncthreads();
        f32x4 sum = red[(0 * 8 + wave) * 64 + lane];
#pragma unroll
        for (int w = 1; w < 8; ++w) sum += red[(w * 8 + wave) * 64 + lane];
        E.template put<ATOMIC>(NPROMPT + wave * 16 + fr, n0 + fq * 4, sum);
    }
}
__device__ __forceinline__ void gl_direct(int lane, int gw, int NGW, const bf16_t* XN, const bf16_t* Bt, float* GL) {
    const int fr = lane & 15, fq = lane >> 4;
    const bf16_t* bp = Bt + (size_t)(3072 + fr) * 1024 + fq * 8;
    for (int mt = gw; mt < NPROMPT / 16; mt += NGW) {
        const bf16_t* ap = XN + (size_t)(mt * 16 + fr) * 1024 + fq * 8;
        f32x4 acc = (f32x4){0.f, 0.f, 0.f, 0.f};
        for (int kk = 0; kk < 1024; kk += 256) {
            bf16x8 a[8], b[8];
#pragma unroll
            for (int i = 0; i < 8; ++i) { a[i] = *(const bf16x8*)(ap + kk + 32 * i); b[i] = *(const bf16x8*)(bp + kk + 32 * i); }
#pragma unroll
            for (int i = 0; i < 8; ++i) acc = __builtin_amdgcn_mfma_f32_16x16x32_bf16(b[i], a[i], acc, 0, 0, 0);
        }
        *(f32x4*)(GL + (size_t)(mt * 16 + fr) * 16 + fq * 4) = acc;
    }
}
}

struct Ctx { int tid, lane, wave, gw, NGW; };

__device__ __forceinline__ void wprep(const Ctx& c, LAS float* scr, int& base, const float* src, int Ks, int Ns, int lsrc, bf16_t* dst, int Kd, int Nd, int ldd, int roff, int coff, const float* mu, int mode) {
    const int nblk = Nd / 32, nitems = (Kd / 64) * nblk;
    int first = (c.gw - (base % c.NGW) + c.NGW) % c.NGW;
    base += nitems;
    const int lane = c.lane;
    for (int it = first; it < nitems; it += c.NGW) {
        const int kb = it / nblk, nb = it % nblk, k0 = 64 * kb, n0 = 32 * nb;
        const int kr = lane >> 3, n4 = (lane & 7) * 4, n = n0 + n4;
        f32x4 v[8];
#pragma unroll
        for (int i = 0; i < 8; ++i) {
            const int k = k0 + kr + 8 * i;
            v[i] = (f32x4){0.f, 0.f, 0.f, 0.f};
            if (k < Ks && n < Ns) { v[i] = *(const f32x4*)(src + (size_t)k * lsrc + n); if (mode == 1) v[i] = v[i] * mu[k]; else if (mode == 2) v[i] = v[i] * (1.0f - mu[k]); else if (mode == 3) v[i] = v[i] * *(const f32x4*)(mu + n); }
        }
#pragma unroll
        for (int i = 0; i < 8; ++i) { LAS float* d = scr + (kr + 8 * i) * 33 + n4; d[0] = v[i][0]; d[1] = v[i][1]; d[2] = v[i][2]; d[3] = v[i][3]; }
        LDS_WAIT();
        const int cc = lane & 7;
#pragma unroll
        for (int j = 0; j < 4; ++j) { const int nn = (lane >> 3) + 8 * j; const LAS float* s = scr + (8 * cc) * 33 + nn;
            u32x4 o; o.x = pk2(s[0 * 33], s[1 * 33]); o.y = pk2(s[2 * 33], s[3 * 33]); o.z = pk2(s[4 * 33], s[5 * 33]); o.w = pk2(s[6 * 33], s[7 * 33]);
            *(u32x4*)(dst + (size_t)(roff + n0 + nn) * ldd + coff + k0 + 8 * cc) = o; }
        LDS_WAIT();
    }
}
__device__ __forceinline__ void wprep_ffn(const Ctx& c, LAS float* scr, int& base, const Params& P, int l) {
    wprep(c, scr, base, P.in(10) + (size_t)l * 4194304, 1024, 4096, 4096, (bf16_t*)(P.ws + R_W + W_UP), 1024, 4096, 1024, 0, 0, nullptr, 0);
    wprep(c, scr, base, P.in(11) + (size_t)l * 4194304, 4096, 1024, 1024, (bf16_t*)(P.ws + R_W + W_DOWN), 4096, 1024, 4096, 0, 0, nullptr, 0);
}

__device__ __forceinline__ float load_row_rstd(const float* xr, int lane, f32x4 (&v)[4], float eps) {
    float s = 0.f;
#pragma unroll
    for (int j = 0; j < 4; ++j) { v[j] = *(const f32x4*)(xr + lane * 4 + 256 * j); s += (v[j][0] * v[j][0] + v[j][1] * v[j][1]) + (v[j][2] * v[j][2] + v[j][3] * v[j][3]); }
    return 1.0f / sqrtf(wave_sum(s) * (1.0f / 1024.0f) + eps);
}

template <bool TOF32>
__device__ __forceinline__ void norm_rows(const Ctx& c, const float* h, const float* g, bf16_t* XN, float* F32) {
    f32x4 v[4], vn[4], gg[4];
#pragma unroll
    for (int j = 0; j < 4; ++j) gg[j] = *(const f32x4*)(g + c.lane * 4 + 256 * j);
    int m = c.gw;
    if (m < MREAL) {
#pragma unroll
        for (int j = 0; j < 4; ++j) v[j] = *(const f32x4*)(h + (size_t)m * 1024 + c.lane * 4 + 256 * j); }
    while (m < MREAL) {
        const int mn = m + c.NGW;
        if (mn < MREAL) {
#pragma unroll
            for (int j = 0; j < 4; ++j) vn[j] = *(const f32x4*)(h + (size_t)mn * 1024 + c.lane * 4 + 256 * j); }
        float ssq = 0.f;
#pragma unroll
        for (int j = 0; j < 4; ++j) ssq += (v[j][0] * v[j][0] + v[j][1] * v[j][1]) + (v[j][2] * v[j][2] + v[j][3] * v[j][3]);
        const float rstd = 1.0f / sqrtf(wave_sum(ssq) * (1.0f / 1024.0f) + 1e-6f);
#pragma unroll
        for (int j = 0; j < 4; ++j) {
            const f32x4 y = v[j] * rstd * gg[j];
            if constexpr (TOF32) *(f32x4*)(F32 + (size_t)m * 1024 + c.lane * 4 + 256 * j) = y;
            else *(u32x2*)(XN + (size_t)m * 1024 + c.lane * 4 + 256 * j) = pk4(y);
        }
#pragma unroll
        for (int j = 0; j < 4; ++j) v[j] = vn[j];
        m = mn;
    }
}
__device__ __forceinline__ void norm_to_xn(const Ctx& c, const float* h, const float* g, bf16_t* XN) { norm_rows<false>(c, h, g, XN, nullptr); }

__device__ __forceinline__ void rwkv_prep(const Ctx& c, const Params& P) {
    float* h = P.out; bf16_t* U2 = (bf16_t*)(P.ws + R_BIG + B_U2);
    const float* g = P.in(7); const float* xp = P.in(0); const float* xs = P.in(1); const float* shs = P.in(3);
    f32x4 v[4], vn[4], gg[4];
#pragma unroll
    for (int j = 0; j < 4; ++j) gg[j] = *(const f32x4*)(g + c.lane * 4 + 256 * j);
    int m = c.gw;
    if (m < MREAL) { const float* xr = m < NPROMPT ? xp + (size_t)m * 1024 : xs + (size_t)(m - NPROMPT) * 1024;
#pragma unroll
        for (int j = 0; j < 4; ++j) v[j] = *(const f32x4*)(xr + c.lane * 4 + 256 * j); }
    while (m < MREAL) {
        const int mn = m + c.NGW;
        if (mn < MREAL) { const float* xr = mn < NPROMPT ? xp + (size_t)mn * 1024 : xs + (size_t)(mn - NPROMPT) * 1024;
#pragma unroll
            for (int j = 0; j < 4; ++j) vn[j] = *(const f32x4*)(xr + c.lane * 4 + 256 * j); }
        bf16_t* u2 = U2 + (size_t)m * 2048 + c.lane * 4;
        float ssq = 0.f;
#pragma unroll
        for (int j = 0; j < 4; ++j) ssq += (v[j][0] * v[j][0] + v[j][1] * v[j][1]) + (v[j][2] * v[j][2] + v[j][3] * v[j][3]);
        const float rstd = 1.0f / sqrtf(wave_sum(ssq) * (1.0f / 1024.0f) + 1e-6f);
#pragma unroll
        for (int j = 0; j < 4; ++j) {
            const int col = c.lane * 4 + 256 * j;
            if (m >= NPROMPT) *(f32x4*)(h + (size_t)m * 1024 + col) = v[j];
            const f32x4 u = v[j] * rstd * gg[j];
            const u32x2 ub = pk4(u);
            *(u32x2*)(u2 + 256 * j) = ub;
            if (m < NPROMPT) {
                const int t = m & 2047, b = m >> 11;
                if (t < 2047) *(u32x2*)(u2 + 2048 + 1024 + 256 * j) = ub; else *(f32x4*)(P.out + O_SHP + (size_t)b * 1024 + col) = u;
                if (t == 0) *(u32x2*)(u2 + 1024 + 256 * j) = pk4(u * 0.0f);
            } else {
                const int b = m - NPROMPT;
                *(u32x2*)(u2 + 1024 + 256 * j) = pk4(*(const f32x4*)(shs + (size_t)b * 1024 + col));
                *(f32x4*)(P.out + O_SHS + (size_t)b * 1024 + col) = u;
            }
        }
#pragma unroll
        for (int j = 0; j < 4; ++j) v[j] = vn[j];
        m = mn;
    }
}
__device__ __forceinline__ void rwkv_wprep(const Ctx& c, LAS float* scr, const Params& P) {
    int base = 0;
    bf16_t* B1 = (bf16_t*)(P.ws + R_W + W_MIX1); bf16_t* B2 = (bf16_t*)(P.ws + R_W + W_MIX2);
    const float* mu = P.in(12);
    wprep(c, scr, base, P.in(13) + 0 * 1048576, 1024, 1024, 1024, B1, 1024, 1024, 2048, 0, 0, mu + 0 * 1024, 2);
    wprep(c, scr, base, P.in(13) + 0 * 1048576, 1024, 1024, 1024, B1, 1024, 1024, 2048, 0, 1024, mu + 0 * 1024, 1);
    wprep(c, scr, base, P.in(13) + 1 * 1048576, 1024, 1024, 1024, B1, 1024, 1024, 2048, 1024, 0, mu + 2 * 1024, 2);
    wprep(c, scr, base, P.in(13) + 1 * 1048576, 1024, 1024, 1024, B1, 1024, 1024, 2048, 1024, 1024, mu + 2 * 1024, 1);
    wprep(c, scr, base, P.in(13) + 2 * 1048576, 1024, 1024, 1024, B1, 1024, 1024, 2048, 2048, 0, mu + 3 * 1024, 2);
    wprep(c, scr, base, P.in(13) + 2 * 1048576, 1024, 1024, 1024, B1, 1024, 1024, 2048, 2048, 1024, mu + 3 * 1024, 1);
    wprep(c, scr, base, P.in(15), 1024, 64, 64, B1, 1024, 256, 2048, 3072, 0, mu + 1 * 1024, 2);
    wprep(c, scr, base, P.in(15), 1024, 64, 64, B1, 1024, 256, 2048, 3072, 1024, mu + 1 * 1024, 1);
    wprep(c, scr, base, P.in(18), 1024, 64, 64, B1, 1024, 256, 2048, 3328, 0, mu + 4 * 1024, 2);
    wprep(c, scr, base, P.in(18), 1024, 64, 64, B1, 1024, 256, 2048, 3328, 1024, mu + 4 * 1024, 1);
    wprep(c, scr, base, P.in(20), 1024, 160, 160, B1, 1024, 256, 2048, 3584, 0, mu + 5 * 1024, 2);
    wprep(c, scr, base, P.in(20), 1024, 160, 160, B1, 1024, 256, 2048, 3584, 1024, mu + 5 * 1024, 1);
    wprep(c, scr, base, P.in(16), 64, 1024, 1024, B2, 256, 1024, 256, 0, 0, nullptr, 0);
    wprep(c, scr, base, P.in(19), 64, 1024, 1024, B2, 256, 1024, 256, 1024, 0, nullptr, 0);
    wprep(c, scr, base, P.in(21), 160, 1024, 1024, B2, 256, 1024, 256, 2048, 0, nullptr, 0);
    wprep(c, scr, base, P.in(27), 1024, 1024, 1024, (bf16_t*)(P.ws + R_W + W_WO), 1024, 1024, 1024, 0, 0, nullptr, 0);
    wprep_ffn(c, scr, base, P, 0);
}

struct RwkvVec { f32x4 r, w, k, na, b; };
__device__ __forceinline__ RwkvVec rwkv_derive(const Params& P, f32x4 r, f32x4 k, f32x4 wl, f32x4 a, int c4) {
    const f32x4 kk0 = k * *(const f32x4*)(P.in(22) + c4);
    const float ss = reduce16((kk0[0] * kk0[0] + kk0[1] * kk0[1]) + (kk0[2] * kk0[2] + kk0[3] * kk0[3]));
    const float inv = 1.0f / fmaxf(sqrtf(ss), 1e-12f);
    const f32x4 kk = kk0 * inv;
    const f32x4 ka = *(const f32x4*)(P.in(23) + c4);
    RwkvVec o;
    o.r = r;
    o.k = k * (1.0f + (a - 1.0f) * ka);
    o.b = kk * a;
    o.na = -kk;
#pragma unroll
    for (int j = 0; j < 4; ++j) o.w[j] = fexp(wl[j]);
    return o;
}

__device__ __forceinline__ float reduce8(float v) {
    v += dppmov<0xB1>(v); v += dppmov<0x4E>(v); v += dppmov<0x141>(v); return v;
}
__device__ __forceinline__ void rwkv_scan(const Ctx& c, const Params& P, unsigned char* ldsb) {
    const h16* RKV = (const h16*)(P.ws + R_BIG + B_RKV); const h16* WAG = (const h16*)(P.ws + R_BIG + B_WAG); h16* Y = (h16*)(P.ws + R_BIG + B_Y);
    constexpr int T = 32, NC = SEQ / T;
    constexpr int BUF_FLOATS = 5 * T * 64 + T * 32, YP_FLOATS = T * 32 * 8;
    float* L = (float*)ldsb;
    float* YpB = L + 2 * BUF_FLOATS;
    const int tid = c.tid, lane = c.lane, wave = c.wave;
    const int rr = (wave & 3) * 8 + (lane >> 3), kq = lane & 7;
    const int t2 = tid & 255, pt = t2 >> 4, pc = (t2 & 15) * 4;
    for (int task = blockIdx.x; task < 256; task += gridDim.x) {
        const int chain = task >> 1, half = task & 1, b = chain >> 4, hd = chain & 15;
        const int vrow = half * 32 + rr;
        const int c4 = hd * 64 + pc;
        f32x4 S0 = (f32x4){0.f, 0.f, 0.f, 0.f}, S1 = S0;
        h16x4 pr0, pk0, pv0, pw0, pa0, pr1, pk1, pv1, pw1, pa1;
        const f32x4 kkw = *(const f32x4*)(P.in(22) + c4), kaw = *(const f32x4*)(P.in(23) + c4);
#define RW_ISSUE(ch) do { const size_t m_ = (size_t)b * SEQ + (ch) * T + pt; \
            pr0 = *(const h16x4*)(RKV + m_ * 3072 + c4); pk0 = *(const h16x4*)(RKV + m_ * 3072 + 1024 + c4); pv0 = *(const h16x4*)(RKV + m_ * 3072 + 2048 + c4); \
            pw0 = *(const h16x4*)(WAG + m_ * 3072 + c4); pa0 = *(const h16x4*)(WAG + m_ * 3072 + 1024 + c4); \
            pr1 = *(const h16x4*)(RKV + (m_ + 16) * 3072 + c4); pk1 = *(const h16x4*)(RKV + (m_ + 16) * 3072 + 1024 + c4); pv1 = *(const h16x4*)(RKV + (m_ + 16) * 3072 + 2048 + c4); \
            pw1 = *(const h16x4*)(WAG + (m_ + 16) * 3072 + c4); pa1 = *(const h16x4*)(WAG + (m_ + 16) * 3072 + 1024 + c4); } while (0)
#define RW_DERIVE1(B_, tt_, r_, k_, v_, w_, a_) do { const f32x4 kf_ = f4(k_), af_ = f4(a_), wf_ = f4(w_); const f32x4 kk0_ = kf_ * kkw; \
            const float ss_ = reduce16((kk0_[0] * kk0_[0] + kk0_[1] * kk0_[1]) + (kk0_[2] * kk0_[2] + kk0_[3] * kk0_[3])); \
            const f32x4 kk_ = kk0_ * (1.0f / fmaxf(sqrtf(ss_), 1e-12f)); \
            f32x4 wd_; wd_[0] = fexp(wf_[0]); wd_[1] = fexp(wf_[1]); wd_[2] = fexp(wf_[2]); wd_[3] = fexp(wf_[3]); \
            *(f32x4*)(B_ + 0 * T * 64 + (tt_) * 64 + pc) = f4(r_); *(f32x4*)(B_ + 1 * T * 64 + (tt_) * 64 + pc) = wd_; \
            *(f32x4*)(B_ + 2 * T * 64 + (tt_) * 64 + pc) = kf_ * (1.0f + (af_ - 1.0f) * kaw); \
            *(f32x4*)(B_ + 3 * T * 64 + (tt_) * 64 + pc) = -kk_; *(f32x4*)(B_ + 4 * T * 64 + (tt_) * 64 + pc) = kk_ * af_; \
            if ((pc >> 5) == half) *(f32x4*)(B_ + 5 * T * 64 + (tt_) * 32 + (pc & 31)) = f4(v_); } while (0)
#define RW_DERIVE(buf) do { float* Bd_ = L + (buf) * BUF_FLOATS; RW_DERIVE1(Bd_, pt, pr0, pk0, pv0, pw0, pa0); RW_DERIVE1(Bd_, pt + 16, pr1, pk1, pv1, pw1, pa1); } while (0)
#define RW_YOUT(ch, ybuf) do { const float* Yq_ = YpB + (ybuf) * YP_FLOATS; _Pragma("unroll") for (int e_ = 0; e_ < 2; ++e_) { \
            const int tt_ = (t2 >> 4) + 16 * e_, r2_ = (t2 & 15) * 2; const float* yp_ = Yq_ + (tt_ * 32 + r2_) * 8; \
            const f32x4 s0_ = *(const f32x4*)(yp_) + *(const f32x4*)(yp_ + 4), s1_ = *(const f32x4*)(yp_ + 8) + *(const f32x4*)(yp_ + 12); \
            h16x2 o_; o_[0] = (h16)((s0_[0] + s0_[1]) + (s0_[2] + s0_[3])); o_[1] = (h16)((s1_[0] + s1_[1]) + (s1_[2] + s1_[3])); \
            *(h16x2*)(Y + ((size_t)b * SEQ + (ch) * T + tt_) * 1024 + hd * 64 + half * 32 + r2_) = o_; } } while (0)
#define RW_LOAD(X, arr, tt_) do { X##0 = *(const f32x4*)(B + (arr) * T * 64 + (tt_) * 64 + kq * 8); X##1 = *(const f32x4*)(B + (arr) * T * 64 + (tt_) * 64 + kq * 8 + 4); } while (0)
#define RW_DOT(a, b) (((a##0[0] * b##0[0] + a##0[1] * b##0[1]) + (a##0[2] * b##0[2] + a##0[3] * b##0[3])) + ((a##1[0] * b##1[0] + a##1[1] * b##1[1]) + (a##1[2] * b##1[2] + a##1[3] * b##1[3])))
        __syncthreads();
        if (wave >= 4) { RW_ISSUE(0); RW_DERIVE(0); RW_ISSUE(1); }
        __syncthreads();
        for (int ch = 0; ch < NC; ++ch) {
            const int buf = ch & 1;
            if (wave < 4) {
                const float* B = L + buf * BUF_FLOATS;
                float* Yp = YpB + buf * YP_FLOATS;
#define LO2(v) __builtin_shufflevector(v, v, 0, 1)
#define HI2(v) __builtin_shufflevector(v, v, 2, 3)
#define RW_LD4(a, b, c, d, arr, tt_) do { const f32x4 x0_ = *(const f32x4*)(B + (arr) * T * 64 + (tt_) * 64 + kq * 8), x1_ = *(const f32x4*)(B + (arr) * T * 64 + (tt_) * 64 + kq * 8 + 4); \
                    a = LO2(x0_); b = HI2(x0_); c = LO2(x1_); d = HI2(x1_); } while (0)
                f32x2 na0, na1, na2, na3, w0, w1, w2, w3, kv0, kv1, kv2, kv3, bb0, bb1, bb2, bb3, rv0, rv1, rv2, rv3; float vv;
                RW_LD4(na0, na1, na2, na3, 3, 0); RW_LD4(w0, w1, w2, w3, 1, 0); RW_LD4(kv0, kv1, kv2, kv3, 2, 0); RW_LD4(bb0, bb1, bb2, bb3, 4, 0); RW_LD4(rv0, rv1, rv2, rv3, 0, 0); vv = B[5 * T * 64 + rr];
                f32x2 Sa = LO2(S0), Sb = HI2(S0), Sc = LO2(S1), Sd = HI2(S1);
#pragma unroll 4
                for (int tt = 0; tt < T; ++tt) {
                    f32x2 xna0, xna1, xna2, xna3, xw0, xw1, xw2, xw3, xkv0, xkv1, xkv2, xkv3, xbb0, xbb1, xbb2, xbb3, xrv0, xrv1, xrv2, xrv3; float xvv;
                    const int tn = (tt + 1 < T) ? tt + 1 : tt;
                    RW_LD4(xna0, xna1, xna2, xna3, 3, tn); RW_LD4(xw0, xw1, xw2, xw3, 1, tn); RW_LD4(xkv0, xkv1, xkv2, xkv3, 2, tn); RW_LD4(xbb0, xbb1, xbb2, xbb3, 4, tn); RW_LD4(xrv0, xrv1, xrv2, xrv3, 0, tn);
                    xvv = B[5 * T * 64 + tn * 32 + rr];
                    f32x2 p = Sa * na0; p = Sb * na1 + p; p = Sc * na2 + p; p = Sd * na3 + p;
                    const float sa = reduce8(p[0] + p[1]);
                    Sa = Sa * w0 + (bb0 * sa + kv0 * vv); Sb = Sb * w1 + (bb1 * sa + kv1 * vv); Sc = Sc * w2 + (bb2 * sa + kv2 * vv); Sd = Sd * w3 + (bb3 * sa + kv3 * vv);
                    f32x2 q = Sa * rv0; q = Sb * rv1 + q; q = Sc * rv2 + q; q = Sd * rv3 + q;
                    Yp[(tt * 32 + rr) * 8 + kq] = q[0] + q[1];
                    na0 = xna0; na1 = xna1; na2 = xna2; na3 = xna3; w0 = xw0; w1 = xw1; w2 = xw2; w3 = xw3; kv0 = xkv0; kv1 = xkv1; kv2 = xkv2; kv3 = xkv3;
                    bb0 = xbb0; bb1 = xbb1; bb2 = xbb2; bb3 = xbb3; rv0 = xrv0; rv1 = xrv1; rv2 = xrv2; rv3 = xrv3; vv = xvv;
                }
                S0 = (f32x4){Sa[0], Sa[1], Sb[0], Sb[1]}; S1 = (f32x4){Sc[0], Sc[1], Sd[0], Sd[1]};
#undef LO2
#undef HI2
#undef RW_LD4
            } else {
                if (ch > 0) RW_YOUT(ch - 1, buf ^ 1);
                if (ch + 1 < NC) { RW_DERIVE(buf ^ 1); if (ch + 2 < NC) RW_ISSUE(ch + 2); }
            }
            LDS_BARRIER();
        }
        if (wave >= 4) RW_YOUT(NC - 1, (NC - 1) & 1);
        else {
            float* so = P.out + O_WKVP + ((size_t)(b * 16 + hd) * 64 + vrow) * 64 + kq * 8;
            *(f32x4*)so = S0; *(f32x4*)(so + 4) = S1;
        }
#undef RW_ISSUE
#undef RW_DERIVE1
#undef RW_DERIVE
#undef RW_YOUT
#undef RW_LOAD
#undef RW_DOT
    }
    {
        const int kq16 = lane & 15;
        const float* st_in = P.in(2); const float* kkp = P.in(22); const float* kap = P.in(23);
        for (int wt0 = c.gw; wt0 < NSB * 16 * 16; wt0 += 4 * c.NGW) {
            f32x4 r[4], k[4], wl[4], a[4], S[4]; float vv[4]; size_t so[4]; int c4v[4]; bool ok[4];
#pragma unroll
            for (int e = 0; e < 4; ++e) {
                const int wt = wt0 + e * c.NGW; ok[e] = wt < NSB * 16 * 16;
                const int wtc = ok[e] ? wt : wt0;
                const int pair = wtc >> 4, rg = wtc & 15, b = pair >> 4, hd = pair & 15;
                const int vrow = rg * 4 + (lane >> 4); c4v[e] = hd * 64 + kq16 * 4;
                const size_t m = (size_t)NPROMPT + b;
                r[e] = f4(*(const h16x4*)(RKV + m * 3072 + c4v[e])); k[e] = f4(*(const h16x4*)(RKV + m * 3072 + 1024 + c4v[e]));
                vv[e] = (float)RKV[m * 3072 + 2048 + hd * 64 + vrow];
                wl[e] = f4(*(const h16x4*)(WAG + m * 3072 + c4v[e])); a[e] = f4(*(const h16x4*)(WAG + m * 3072 + 1024 + c4v[e]));
                so[e] = ((size_t)(b * 16 + hd) * 64 + vrow) * 64 + kq16 * 4;
                S[e] = *(const f32x4*)(st_in + so[e]);
            }
#pragma unroll
            for (int e = 0; e < 4; ++e) {
                const f32x4 kk0 = k[e] * *(const f32x4*)(kkp + c4v[e]);
                const float ss = reduce16((kk0[0] * kk0[0] + kk0[1] * kk0[1]) + (kk0[2] * kk0[2] + kk0[3] * kk0[3]));
                const f32x4 kk = kk0 * (1.0f / fmaxf(sqrtf(ss), 1e-12f));
                const f32x4 kp = k[e] * (1.0f + (a[e] - 1.0f) * *(const f32x4*)(kap + c4v[e]));
                f32x4 wd; wd[0] = fexp(wl[e][0]); wd[1] = fexp(wl[e][1]); wd[2] = fexp(wl[e][2]); wd[3] = fexp(wl[e][3]);
                f32x4 Sx = S[e];
                const float sa = -reduce16((Sx[0] * kk[0] + Sx[1] * kk[1]) + (Sx[2] * kk[2] + Sx[3] * kk[3]));
                Sx = Sx * wd + ((kk * a[e]) * sa + kp * vv[e]);
                const float y = reduce16((Sx[0] * r[e][0] + Sx[1] * r[e][1]) + (Sx[2] * r[e][2] + Sx[3] * r[e][3]));
                if (ok[e]) {
                    __builtin_nontemporal_store(Sx, (f32x4*)(P.out + O_WKVS + so[e]));
                    if (kq16 == 0) Y[((size_t)NPROMPT + (so[e] >> 16)) * 1024 + ((so[e] >> 6) & 1023)] = (h16)y;
                }
            }
        }
    }
}

__device__ __forceinline__ void rwkv_post(const Ctx& c, const Params& P) {
    const h16* RKV = (const h16*)(P.ws + R_BIG + B_RKV); const h16* WAG = (const h16*)(P.ws + R_BIG + B_WAG); const h16* Y = (const h16*)(P.ws + R_BIG + B_Y);
    bf16_t* XN = (bf16_t*)(P.ws + R_XN);
    const float* pka = P.in(23); const float* prk = P.in(24); const float* plw = P.in(25); const float* plb = P.in(26);
    f32x4 ka[4], rkw[4], lw[4], lb[4];
#pragma unroll
    for (int j = 0; j < 4; ++j) { const int col = c.lane * 4 + 256 * j; ka[j] = *(const f32x4*)(pka + col); rkw[j] = *(const f32x4*)(prk + col); lw[j] = *(const f32x4*)(plw + col); lb[j] = *(const f32x4*)(plb + col); }
#define RP_LOAD(X, m_) do { _Pragma("unroll") for (int j_ = 0; j_ < 4; ++j_) { const int col_ = c.lane * 4 + 256 * j_; \
        X##y[j_] = *(const h16x4*)(Y + (size_t)(m_) * 1024 + col_); X##r[j_] = *(const h16x4*)(RKV + (size_t)(m_) * 3072 + col_); X##k[j_] = *(const h16x4*)(RKV + (size_t)(m_) * 3072 + 1024 + col_); \
        X##v[j_] = *(const h16x4*)(RKV + (size_t)(m_) * 3072 + 2048 + col_); X##a[j_] = *(const h16x4*)(WAG + (size_t)(m_) * 3072 + 1024 + col_); X##g[j_] = *(const h16x4*)(WAG + (size_t)(m_) * 3072 + 2048 + col_); } } while (0)
    h16x4 cy[4], cr[4], ck[4], cv[4], ca[4], cg[4], ny[4], nr[4], nk[4], nv[4], na[4], ng[4];
    int m = c.gw;
    if (m < MREAL) RP_LOAD(c, m);
    while (m < MREAL) {
        const int mn = m + c.NGW;
        if (mn < MREAL) RP_LOAD(n, mn);
#pragma unroll
        for (int j = 0; j < 4; ++j) {
            const int col = c.lane * 4 + 256 * j;
            const f32x4 y = f4(cy[j]), r = f4(cr[j]), k = f4(ck[j]), v = f4(cv[j]), a = f4(ca[j]), g = f4(cg[j]);
            const float mean = reduce16((y[0] + y[1]) + (y[2] + y[3])) * (1.0f / 64.0f);
            const f32x4 dy = y - mean;
            const float var = reduce16((dy[0] * dy[0] + dy[1] * dy[1]) + (dy[2] * dy[2] + dy[3] * dy[3])) * (1.0f / 64.0f);
            const float rs = 1.0f / sqrtf(var + 64e-5f);
            const f32x4 kp = k * (1.0f + (a - 1.0f) * ka[j]);
            const f32x4 rk = r * kp * rkw[j];
            const float bon = reduce16((rk[0] + rk[1]) + (rk[2] + rk[3]));
            const f32x4 yn = dy * rs * lw[j] + lb[j];
            *(u32x2*)(XN + (size_t)m * 1024 + col) = pk4((yn + v * bon) * g);
        }
#pragma unroll
        for (int j = 0; j < 4; ++j) { cy[j] = ny[j]; cr[j] = nr[j]; ck[j] = nk[j]; cv[j] = nv[j]; ca[j] = na[j]; cg[j] = ng[j]; }
        m = mn;
    }
#undef RP_LOAD
}

__device__ __forceinline__ float gk_to_e(float x) {
    return fexp(-softplusf_(-x) * (1.0f / 16.0f));
}
__device__ __forceinline__ bf16x8 lds_frag(const bf16_t* base, int row, int ld, int k0) { return *(const bf16x8*)(base + row * ld + k0); }
constexpr size_t B_GREC = B_O + (size_t)MP * 1024 * 4;
constexpr int GREC_HEAD = 45568, GREC_BYTES = 45568 + 36864;
__device__ __forceinline__ void gla_pre(const Ctx& c, const Params& P, unsigned char* ldsb) {
    const h16* Z = (const h16*)(P.ws + R_BIG + B_Z); const float* GL = (const float*)(P.ws + R_BIG + B_GL);
    unsigned char* GREC = P.ws + R_BIG + B_GREC;
    constexpr int CH = 64, NC = SEQ / CH, LDQ = 136, LDT = 72;
    bf16_t* QB  = (bf16_t*)(ldsb);
    bf16_t* KBT = (bf16_t*)(ldsb + 17408);
    bf16_t* ATT = (bf16_t*)(ldsb + 35840);
    float* EL = (float*)(ldsb + 45056);
    bf16_t* KB  = (bf16_t*)(ldsb + 45568);
    h16* QR = (h16*)(ldsb + 62976);
    h16* KR = (h16*)(ldsb + 79360);
    float* GLs = (float*)(ldsb + 95744);
    float* SEG = (float*)(ldsb + 99840);
    bf16_t* VT = (bf16_t*)(ldsb + 101888);
    const int tid = c.tid, lane = c.lane, wave = c.wave;
    const int fr = lane & 15, fq = lane >> 4;
    const int kx = tid & 127, tq = tid >> 7;
    const int lt = tid >> 3, lks = (tid & 7) * 16, vsx = tid & 63, vg = tid >> 6, gt = tid >> 2, g4 = (tid & 3) * 4;
    for (int task = blockIdx.x; task < 32 * NC; task += gridDim.x) {
        const int chain = task / NC, n = task % NC, b = chain >> 2, hd = chain & 3;
        const size_t m0 = (size_t)b * SEQ + n * CH;
        float wg[16];
#pragma unroll
        for (int i = 0; i < 16; ++i) wg[i] = P.in(29)[(size_t)i * 512 + hd * 128 + kx];
        const float bg = P.in(30)[hd * 128 + kx];
        __syncthreads();
        *(h16x8*)(QR + lt * 128 + lks) = *(const h16x8*)(Z + (m0 + lt) * 3072 + hd * 128 + lks); *(h16x8*)(QR + lt * 128 + lks + 8) = *(const h16x8*)(Z + (m0 + lt) * 3072 + hd * 128 + lks + 8);
        *(h16x8*)(KR + lt * 128 + lks) = *(const h16x8*)(Z + (m0 + lt) * 3072 + 512 + hd * 128 + lks); *(h16x8*)(KR + lt * 128 + lks + 8) = *(const h16x8*)(Z + (m0 + lt) * 3072 + 512 + hd * 128 + lks + 8);
        if (tid < 256) *(f32x4*)(GLs + gt * 16 + g4) = *(const f32x4*)(GL + (m0 + gt) * 16 + g4);
#pragma unroll
        for (int i = 0; i < 4; ++i) {
            const h16x8 pv = *(const h16x8*)(Z + (m0 + vsx) * 3072 + 1024 + hd * 256 + vg * 32 + 8 * i);
#pragma unroll
            for (int j = 0; j < 8; ++j) VT[(vg * 32 + 8 * i + j) * LDT + vsx] = (bf16_t)f2bf((float)pv[j]);
        }
        __syncthreads();
        float cb[16]; float run = 0.f;
#pragma unroll
        for (int i = 0; i < 16; ++i) {
            const float* g = GLs + (tq * 16 + i) * 16;
            const f32x4 g0 = *(const f32x4*)g, g1 = *(const f32x4*)(g + 4), g2 = *(const f32x4*)(g + 8), g3 = *(const f32x4*)(g + 12);
            float x = bg;
#pragma unroll
            for (int j = 0; j < 4; ++j) x += g0[j] * wg[j] + g1[j] * wg[4 + j] + g2[j] * wg[8 + j] + g3[j] * wg[12 + j];
            run += -softplusf_(-x) * (1.0f / 16.0f);
            cb[i] = run;
        }
        SEG[tq * 128 + kx] = run;
        __syncthreads();
        {
            const float s0 = SEG[kx], s1 = SEG[128 + kx], s2 = SEG[256 + kx], s3 = SEG[384 + kx];
            const float off = (tq > 0 ? s0 : 0.f) + (tq > 1 ? s1 : 0.f) + (tq > 2 ? s2 : 0.f);
            unsigned kt[8];
#pragma unroll
            for (int i = 0; i < 16; ++i) {
                const int t = tq * 16 + i;
                const float bb = fmaxf(off + cb[i], -80.f);
                const float eb = fexp(bb), enb = __builtin_amdgcn_rcpf(eb);
                const float qv = (float)QR[t * 128 + kx] * 0.08838834764831845f * eb, kv = (float)KR[t * 128 + kx] * enb;
                QB[t * LDQ + kx] = (bf16_t)f2bf(qv);
                const unsigned kb = f2bf(kv);
                KB[t * LDQ + kx] = (bf16_t)kb;
                if (i & 1) kt[i >> 1] |= kb << 16; else kt[i >> 1] = kb;
            }
            *(u32x4*)(KBT + kx * LDT + tq * 16) = (u32x4){kt[0], kt[1], kt[2], kt[3]};
            *(u32x4*)(KBT + kx * LDT + tq * 16 + 8) = (u32x4){kt[4], kt[5], kt[6], kt[7]};
            if (tq == 0) EL[kx] = fexp(fmaxf((s0 + s1) + (s2 + s3), -80.f));
        }
        __syncthreads();
        {
            const int si = wave & 3;
#pragma unroll
            for (int tj = 0; tj < 2; ++tj) {
                const int ti = 2 * (wave >> 2) + tj;
                f32x4 acc = (f32x4){0.f, 0.f, 0.f, 0.f};
                if (si <= ti) {
#pragma unroll
                    for (int kk = 0; kk < 4; ++kk)
                        acc = __builtin_amdgcn_mfma_f32_16x16x32_bf16(lds_frag(KB, si * 16 + fr, LDQ, kk * 32 + fq * 8), lds_frag(QB, ti * 16 + fr, LDQ, kk * 32 + fq * 8), acc, 0, 0, 0);
                }
                const int t = ti * 16 + fr, sb = si * 16 + fq * 4;
#pragma unroll
                for (int j = 0; j < 4; ++j) if (sb + j > t) acc[j] = 0.f;
                *(u32x2*)(ATT + t * LDT + sb) = pk4(acc);
            }
        }
        __syncthreads();
        {
            unsigned char* rec = GREC + (size_t)task * GREC_BYTES;
            for (int u = tid; u < GREC_HEAD / 16; u += 512) *(u32x4*)(rec + u * 16) = *(const u32x4*)(ldsb + u * 16);
            for (int u = tid; u < 36864 / 16; u += 512) *(u32x4*)(rec + GREC_HEAD + u * 16) = *(const u32x4*)((const unsigned char*)VT + u * 16);
        }
    }
}
__device__ __forceinline__ void gla_scan(const Ctx& c, const Params& P, unsigned char* ldsb) {
    const h16* Z = (const h16*)(P.ws + R_BIG + B_Z); const float* GL = (const float*)(P.ws + R_BIG + B_GL); float* O = (float*)(P.ws + R_BIG + B_O);
    const unsigned char* GREC = P.ws + R_BIG + B_GREC;
    constexpr int CH = 64, NC = SEQ / CH, LDQ = 136, LDT = 72;
    bf16_t* QB  = (bf16_t*)(ldsb);
    bf16_t* KBT = (bf16_t*)(ldsb + 17408);
    bf16_t* ATT = (bf16_t*)(ldsb + 35840);
    float* EL = (float*)(ldsb + 45056);
    bf16_t* VT = (bf16_t*)(ldsb + 45568);
    bf16_t* ST = (bf16_t*)(ldsb + 50176);
    float* L = (float*)ldsb;
    float* LE = L; float* LK = L + 128; float* LQ = L + 256; float* LOP = L + 384;
    const int tid = c.tid, lane = c.lane, wave = c.wave;
    const int fr = lane & 15, fq = lane >> 4;
    for (int task = blockIdx.x; task < 256; task += gridDim.x) {
        const int chain = task >> 3, vs = task & 7, b = chain >> 2, hd = chain & 3;
        __syncthreads();
        for (int i = tid; i < 2 * 32 * LDQ / 2; i += 512) ((unsigned*)ST)[i] = 0u;
        f32x4 Sacc[2]; Sacc[0] = (f32x4){0.f, 0.f, 0.f, 0.f}; Sacc[1] = Sacc[0];
        u32x4 preA[7], preB[7];
#define GL_ISSUE(X, n) do { const unsigned char* rec_ = GREC + (size_t)(chain * NC + (n)) * GREC_BYTES; \
            _Pragma("unroll") for (int i_ = 0; i_ < 6; ++i_) { const int u_ = tid + 512 * i_; if (u_ < GREC_HEAD / 16) pre##X[i_] = *(const u32x4*)(rec_ + u_ * 16); } \
            if (tid < 288) pre##X[6] = *(const u32x4*)(rec_ + GREC_HEAD + vs * 4608 + tid * 16); } while (0)
#define GL_FILL(X) do { _Pragma("unroll") for (int i_ = 0; i_ < 6; ++i_) { const int u_ = tid + 512 * i_; if (u_ < GREC_HEAD / 16) *(u32x4*)(ldsb + u_ * 16) = pre##X[i_]; } \
            if (tid < 288) *(u32x4*)((unsigned char*)VT + tid * 16) = pre##X[6]; } while (0)
        GL_ISSUE(A, 0); GL_ISSUE(B, 1);
        int cur = 0;
        for (int n = 0; n < NC; ++n) {
            const size_t m0 = (size_t)b * SEQ + n * CH;
            if (n & 1) GL_FILL(B); else GL_FILL(A);
            LDS_BARRIER();
            if (n + 2 < NC) { if (n & 1) GL_ISSUE(B, n + 2); else GL_ISSUE(A, n + 2); }
            {
                const int ti = wave >> 1, vi = wave & 1;
                const bf16_t* STc = ST + cur * 32 * LDQ;
                f32x4 acc = (f32x4){0.f, 0.f, 0.f, 0.f};
#pragma unroll
                for (int kk = 0; kk < 4; ++kk)
                    acc = __builtin_amdgcn_mfma_f32_16x16x32_bf16(lds_frag(STc, vi * 16 + fr, LDQ, kk * 32 + fq * 8), lds_frag(QB, ti * 16 + fr, LDQ, kk * 32 + fq * 8), acc, 0, 0, 0);
#pragma unroll
                for (int kk = 0; kk < 2; ++kk)
                    acc = __builtin_amdgcn_mfma_f32_16x16x32_bf16(lds_frag(VT, vi * 16 + fr, LDT, kk * 32 + fq * 8), lds_frag(ATT, ti * 16 + fr, LDT, kk * 32 + fq * 8), acc, 0, 0, 0);
                *(f32x4*)(O + (m0 + ti * 16 + fr) * 1024 + hd * 256 + vs * 32 + vi * 16 + fq * 4) = acc;
            }
            {
                bf16_t* STn = ST + (cur ^ 1) * 32 * LDQ;
                const f32x4 el = *(const f32x4*)(EL + wave * 16 + fq * 4);
#pragma unroll
                for (int vi = 0; vi < 2; ++vi) {
                    f32x4 acc = Sacc[vi];
#pragma unroll
                    for (int kk = 0; kk < 2; ++kk)
                        acc = __builtin_amdgcn_mfma_f32_16x16x32_bf16(lds_frag(KBT, wave * 16 + fr, LDT, kk * 32 + fq * 8), lds_frag(VT, vi * 16 + fr, LDT, kk * 32 + fq * 8), acc, 0, 0, 0);
                    acc = acc * el;
                    Sacc[vi] = acc;
                    *(u32x2*)(STn + (vi * 16 + fr) * LDQ + wave * 16 + fq * 4) = pk4(acc);
                }
            }
            LDS_BARRIER();
            cur ^= 1;
        }
#undef GL_FILL
#undef GL_ISSUE
#pragma unroll
        for (int vi = 0; vi < 2; ++vi)
#pragma unroll
            for (int j = 0; j < 4; ++j) P.out[O_GLAP + ((size_t)(b * 4 + hd) * 128 + wave * 16 + fq * 4 + j) * 256 + vs * 32 + vi * 16 + fr] = Sacc[vi][j];
    }
    {
        const float* st_in = P.in(4); const float* wgk = P.in(29); const float* bgk = P.in(30);
        for (int pair = blockIdx.x; pair < NSB * 4; pair += gridDim.x) {
            const int b = pair >> 2, hd = pair & 3;
            const size_t m = (size_t)NPROMPT + b;
            __syncthreads();
            if (tid < 128) {
                float x = bgk[hd * 128 + tid];
#pragma unroll
                for (int i = 0; i < 16; ++i) x += GL[m * 16 + i] * wgk[(size_t)i * 512 + hd * 128 + tid];
                LE[tid] = gk_to_e(x); LK[tid] = (float)Z[m * 3072 + 512 + hd * 128 + tid]; LQ[tid] = (float)Z[m * 3072 + hd * 128 + tid] * 0.08838834764831845f;
            }
            __syncthreads();
            const int v4 = (tid & 63) * 4, kg = tid >> 6;
            const f32x4 vval = f4(*(const h16x4*)(Z + m * 3072 + 1024 + hd * 256 + v4));
            f32x4 o = (f32x4){0.f, 0.f, 0.f, 0.f};
            const size_t sb = ((size_t)(b * 4 + hd) * 128 + kg * 16) * 256 + v4;
#pragma unroll
            for (int hb = 0; hb < 2; ++hb) {
                f32x4 s0[8];
#pragma unroll
                for (int j = 0; j < 8; ++j) s0[j] = *(const f32x4*)(st_in + sb + (size_t)(hb * 8 + j) * 256);
#pragma unroll
                for (int j = 0; j < 8; ++j) {
                    const int k = kg * 16 + hb * 8 + j;
                    const f32x4 sn = s0[j] * LE[k] + vval * LK[k];
                    o += sn * LQ[k];
                    __builtin_nontemporal_store(sn, (f32x4*)(P.out + O_GLAS + sb + (size_t)(hb * 8 + j) * 256));
                }
            }
            *(f32x4*)(LOP + kg * 256 + v4) = o;
            __syncthreads();
            if (tid < 256) { float r = 0.f;
#pragma unroll
                for (int g = 0; g < 8; ++g) r += LOP[g * 256 + tid];
                O[m * 1024 + hd * 256 + tid] = r; }
        }
    }
}
__device__ __forceinline__ void gla_post(const Ctx& c, const Params& P) {
    const h16* Z = (const h16*)(P.ws + R_BIG + B_Z); const float* O = (const float*)(P.ws + R_BIG + B_O); bf16_t* XN = (bf16_t*)(P.ws + R_XN);
    const f32x4 nw = *(const f32x4*)(P.in(31) + c.lane * 4);
#define GP_LOAD(X, m_) do { _Pragma("unroll") for (int j_ = 0; j_ < 4; ++j_) { const int col_ = c.lane * 4 + 256 * j_; \
        X##o[j_] = *(const f32x4*)(O + (size_t)(m_) * 1024 + col_); X##g[j_] = *(const h16x4*)(Z + (size_t)(m_) * 3072 + 2048 + col_); } } while (0)
    f32x4 co[4], no[4]; h16x4 cg[4], ng[4];
    int m = c.gw;
    if (m < MREAL) GP_LOAD(c, m);
    while (m < MREAL) {
        const int mn = m + c.NGW;
        if (mn < MREAL) GP_LOAD(n, mn);
#pragma unroll
        for (int j = 0; j < 4; ++j) {
            const int col = c.lane * 4 + 256 * j;
            const f32x4 o = co[j], g = f4(cg[j]);
            const float ms = wave_sum((o[0] * o[0] + o[1] * o[1]) + (o[2] * o[2] + o[3] * o[3])) * (1.0f / 256.0f);
            const float rs = 1.0f / sqrtf(ms + 1e-5f);
            f32x4 r;
#pragma unroll
            for (int i = 0; i < 4; ++i) r[i] = o[i] * rs * nw[i] * (g[i] * sigmoidf_(g[i]));
            *(u32x2*)(XN + (size_t)m * 1024 + col) = pk4(r);
        }
#pragma unroll
        for (int j = 0; j < 4; ++j) { co[j] = no[j]; cg[j] = ng[j]; }
        m = mn;
    }
#undef GP_LOAD
}

__device__ __forceinline__ f32x4 conv_zc(const h16* Z, size_t m, int col) { return f4(*(const h16x4*)(Z + m * 3072 + 1024 + col)) * f4(*(const h16x4*)(Z + m * 3072 + 2048 + col)); }
__device__ __forceinline__ void conv_mid(const Ctx& c, const Params& P) {
    const h16* Z = (const h16*)(P.ws + R_BIG + B_Z); bf16_t* XN = (bf16_t*)(P.ws + R_XN);
    const float* cw = P.in(34);
    for (int m = c.gw; m < MP; m += c.NGW) {
        if (m >= MREAL) continue;
#pragma unroll
        for (int j = 0; j < 4; ++j) {
            const int col = c.lane * 4 + 256 * j;
            const f32x4 z0 = conv_zc(Z, m, col);
            f32x4 z1 = (f32x4){0.f, 0.f, 0.f, 0.f}, z2 = z1;
            if (m < NPROMPT) {
                const int t = m & 2047, b = m >> 11;
                if (t >= 1) z1 = conv_zc(Z, m - 1, col);
                if (t >= 2) z2 = conv_zc(Z, m - 2, col);
                if (t >= 2046) *(f32x4*)(P.out + O_CONVP + ((size_t)b * 2 + (t - 2046)) * 1024 + col) = z0;
            } else {
                const int b = m - NPROMPT;
                z2 = *(const f32x4*)(P.in(5) + ((size_t)b * 2 + 0) * 1024 + col);
                z1 = *(const f32x4*)(P.in(5) + ((size_t)b * 2 + 1) * 1024 + col);
                *(f32x4*)(P.out + O_CONVS + ((size_t)b * 2 + 0) * 1024 + col) = z1;
                *(f32x4*)(P.out + O_CONVS + ((size_t)b * 2 + 1) * 1024 + col) = z0;
            }
            const f32x4 cv = *(const f32x4*)(cw + col) * z2 + *(const f32x4*)(cw + 1024 + col) * z1 + *(const f32x4*)(cw + 2048 + col) * z0;
            const f32x4 gB = f4(*(const h16x4*)(Z + (size_t)m * 3072 + col));
            *(u32x2*)(XN + (size_t)m * 1024 + col) = pk4(gB * cv);
        }
    }
}

__device__ __forceinline__ void pool_norm(const Ctx& c, const Params& P) {
    norm_rows<true>(c, P.out, P.in(7) + 3 * 1024, nullptr, (float*)(P.ws + R_BIG));
}
__device__ __forceinline__ void pool_mid(const Ctx& c, const Params& P) {
    const float* U = (const float*)(P.ws + R_BIG); bf16_t* XN = (bf16_t*)(P.ws + R_XN);
    const float* buf = P.in(6);
    for (int m = c.gw; m < MREAL; m += c.NGW) {
        f32x4 u[4], s[4]; float cnt[4];
        if (m < NPROMPT) {
            const int t = m & 2047;
#pragma unroll
            for (int j = 0; j < 4; ++j) {
                const int col = c.lane * 4 + 256 * j, w = 2 << j;
                u[j] = *(const f32x4*)(U + (size_t)m * 1024 + col);
                f32x4 a = u[j];
                if (t + 1 >= w) {
#pragma unroll
                    for (int i = 1; i < w; ++i) a += *(const f32x4*)(U + (size_t)(m - i) * 1024 + col);
                    cnt[j] = (float)w;
                } else {
                    for (int i = 1; i <= t; ++i) a += *(const f32x4*)(U + (size_t)(m - i) * 1024 + col);
                    cnt[j] = (float)(t + 1);
                }
                s[j] = a;
            }
        } else {
            const int b = m - NPROMPT;
#pragma unroll
            for (int j = 0; j < 4; ++j) {
                const int col = c.lane * 4 + 256 * j, w = 2 << j;
                u[j] = *(const f32x4*)(U + (size_t)m * 1024 + col);
                f32x4 a = u[j];
#pragma unroll
                for (int i = 1; i < w; ++i) a += *(const f32x4*)(buf + ((size_t)b * 15 + (15 - i)) * 1024 + col);
                cnt[j] = (float)w; s[j] = a;
            }
        }
#pragma unroll
        for (int j = 0; j < 4; ++j) {
            const int col = c.lane * 4 + 256 * j;
            *(u32x2*)(XN + (size_t)m * 1024 + col) = pk4(s[j] / cnt[j] - u[j]);
            if (m < NPROMPT) { const int t = m & 2047, b = m >> 11;
                if (t >= SEQ - 15) *(f32x4*)(P.out + O_POOLP + ((size_t)b * 15 + (t - (SEQ - 15))) * 1024 + col) = u[j]; }
        }
        if (m >= NPROMPT) {
            const int b = m - NPROMPT;
            for (int i = 0; i < 15; ++i)
#pragma unroll
                for (int j = 0; j < 4; ++j) {
                    const int col = c.lane * 4 + 256 * j;
                    const f32x4 val = (i < 14) ? *(const f32x4*)(buf + ((size_t)b * 15 + i + 1) * 1024 + col) : u[j];
                    *(f32x4*)(P.out + O_POOLS + ((size_t)b * 15 + i) * 1024 + col) = val;
                }
        }
    }
}

#define XB_TMO      128
#define XB_XCNT(j)  (256  + 64 * (j))
#define XB_XSUB(j)  (1280 + 64 * (j))
#define XB_XGEN(j)  (2304 + 64 * (j))
#define XB_TOP      3328
#define XB_TOPGEN   3392
#define XCD_BAR_WORDS 3456
#define XB_SPIN_CAP (1u << 18)
__device__ __forceinline__ unsigned xb_ld(unsigned* p)              { return __hip_atomic_load(p, __ATOMIC_RELAXED, __HIP_MEMORY_SCOPE_AGENT); }
__device__ __forceinline__ unsigned xb_add(unsigned* p, unsigned v) { return __hip_atomic_fetch_add(p, v, __ATOMIC_RELAXED, __HIP_MEMORY_SCOPE_AGENT); }
__device__ __forceinline__ unsigned xb_xcc_id() { return (unsigned)__builtin_amdgcn_s_getreg((3 << 11) | 20) & 0xFu; }
#define XB_SPIN(cond, bar) do { unsigned _sp = 0; while (cond) { __builtin_amdgcn_s_sleep(1); \
    if ((++_sp & 255u) == 0u) { if (xb_ld(&(bar)[XB_TMO])) break; if (_sp > XB_SPIN_CAP) { atomicAdd(&(bar)[XB_TMO], 1u); break; } } } } while (0)
struct XcdBarrier { unsigned* bar; unsigned x; volatile LAS unsigned* st; };
__device__ __forceinline__ void xcd_barrier_complete(unsigned* bar, unsigned x, unsigned& nloc, unsigned& nx) {
    const unsigned G = gridDim.x * gridDim.y * gridDim.z;
    unsigned sum, cnt, mine, sp = 0u;
    for (;;) {
        sum = 0u; cnt = 0u; mine = 0u;
#pragma unroll
        for (unsigned j = 0; j < 16; ++j) { const unsigned c = xb_ld(&bar[XB_XCNT(j)]); sum += c; cnt += (c > 0u) ? 1u : 0u; mine = (j == x) ? c : mine; }
        if (sum == G) break;
        __builtin_amdgcn_s_sleep(1);
        if ((++sp & 255u) == 0u) { if (xb_ld(&bar[XB_TMO])) break; if (sp > XB_SPIN_CAP) { atomicAdd(&bar[XB_TMO], 1u); break; } }
    }
    nloc = mine > 0u ? mine : 1u; nx = cnt > 0u ? cnt : 1u;
}
__device__ __forceinline__ void xcd_barrier(const XcdBarrier& b) {
    asm volatile("s_waitcnt vmcnt(0)" ::: "memory");
    __syncthreads();
    if (threadIdx.x == 0) {
        unsigned* bar = b.bar;
        __builtin_amdgcn_s_waitcnt(0);
        unsigned nloc = b.st[0], nx = b.st[1];
        if (nloc == 0u) { xcd_barrier_complete(bar, b.x, nloc, nx); b.st[0] = nloc; b.st[1] = nx; }
        const unsigned old = xb_add(&bar[XB_XSUB(b.x)], 1u);
        const unsigned gen = old / nloc;
        if (old + 1u == (gen + 1u) * nloc) {
            __builtin_amdgcn_fence(__ATOMIC_RELEASE, "agent");
            asm volatile("s_waitcnt vmcnt(0)" ::: "memory");
            const unsigned og = xb_add(&bar[XB_TOP], 1u);
            const unsigned tg = og / nx;
            if (og + 1u == (tg + 1u) * nx) xb_add(&bar[XB_TOPGEN], 1u);
            else XB_SPIN(xb_ld(&bar[XB_TOPGEN]) == tg, bar);
            __builtin_amdgcn_fence(__ATOMIC_ACQUIRE, "agent");
            xb_add(&bar[XB_XGEN(b.x)], 1u);
            asm volatile("s_waitcnt vmcnt(0)" ::: "memory");
        } else {
            XB_SPIN(xb_ld(&bar[XB_XGEN(b.x)]) == gen, bar);
            __builtin_amdgcn_fence(__ATOMIC_ACQUIRE, "agent");
            asm volatile("s_waitcnt vmcnt(0)" ::: "memory");
        }
    }
    __syncthreads();
}

__global__ void __launch_bounds__(512, 2) hybrid_fwd(Args A) {
    extern __shared__ __attribute__((aligned(16))) unsigned char lds[];
    cg::grid_group grid = cg::this_grid();
    Params P; P.tab = (LAS unsigned long long*)((LAS unsigned char*)lds + LDS_TAB); P.out = A.out; P.ws = A.ws;
    if (threadIdx.x == 0) {
#pragma unroll
        for (int i = 0; i < 38; ++i) P.tab[i] = (unsigned long long)A.in[i];
        P.tab[40] = 0ull;
    }
    if (blockIdx.x == 0) for (int i = threadIdx.x; i < XCD_BAR_WORDS; i += 512) ((unsigned*)(A.ws + WS_BAR))[i] = 0u;
    __syncthreads();

    Ctx c;
    const int wave0 = __builtin_amdgcn_readfirstlane(threadIdx.x >> 6);
#define FRESH() do { int w_ = wave0; unsigned ones_ = ~0u; asm volatile("" : "+s"(w_), "+s"(ones_)); \
        int l_ = (int)__builtin_amdgcn_mbcnt_hi(ones_, __builtin_amdgcn_mbcnt_lo(ones_, 0u)); asm volatile("" : "+v"(l_)); \
        int g_ = gridDim.x, b_ = blockIdx.x; asm volatile("" : "+s"(g_), "+s"(b_)); G = g_; cid = b_; \
        c.lane = l_; c.wave = w_; c.tid = w_ * 64 + l_; c.gw = b_ * 8 + w_; c.NGW = g_ * 8; \
        unsigned long long o_ = (unsigned long long)A.out, s_ = (unsigned long long)A.ws; asm volatile("" : "+s"(o_), "+s"(s_)); \
        P.out = (float*)(__attribute__((address_space(1))) float*)o_; P.ws = (unsigned char*)(__attribute__((address_space(1))) unsigned char*)s_; \
        h = P.out; XN = (bf16_t*)(P.ws + R_XN); } while (0)
#define SYNC0() do { grid.sync(); FRESH(); if (c.tid == 0) (void)xb_add((unsigned*)(P.ws + WS_BAR) + XB_XCNT(xb_xcc_id()), 1u); } while (0)
#define SYNC() do { XcdBarrier xb; xb.bar = (unsigned*)(P.ws + WS_BAR); xb.x = xb_xcc_id(); xb.st = (volatile LAS unsigned*)(P.tab + 40); xcd_barrier(xb); FRESH(); } while (0)
    LAS unsigned char* ldsl = (LAS unsigned char*)lds;
    LAS float* scr = (LAS float*)(ldsl + wave0 * 8448);
    int G, cid;
    float* h; bf16_t* XN;
    constexpr int NOGRP = 31;
    FRESH();

    for (int l = 0; l < 4; ++l) {
        if (l == 0) {
            rwkv_wprep(c, scr, P);
            rwkv_prep(c, P);
            SYNC0();
            { pg8::Gemm g{(const bf16_t*)(P.ws + R_BIG + B_U2), (const bf16_t*)(P.ws + R_W + W_MIX1), 2048, 2048, 2048, NOGRP, 0u};
              pg8::StaticOrder S; S.init(NPROMPT / 256, 15, G, cid);
              pg8::Epi<pg8::EP_RKV> E{(void*)(P.ws + R_BIG + B_RKV), (void*)(P.ws + R_BIG + B_LH), nullptr, nullptr};
              pg8::gemm_phase(c.tid, ldsl, g, S, E); FRESH(); pg8::thin_gemm<pg8::EP_RKV, false>(c.lane, c.wave, g, 3840, 1, E, lds); }
            SYNC();
            { pg8::Gemm g{(const bf16_t*)(P.ws + R_BIG + B_LH), (const bf16_t*)(P.ws + R_W + W_MIX2), 768, 256, 256, 2, 512u};
              pg8::StaticOrder S; S.init(NPROMPT / 256, 12, G, cid);
              pg8::Epi<pg8::EP_LORA2> E{(void*)(P.ws + R_BIG + B_WAG), nullptr, P.in(14), P.in(17)};
              pg8::gemm_phase(c.tid, ldsl, g, S, E); FRESH(); pg8::thin_gemm<pg8::EP_LORA2, false>(c.lane, c.wave, g, 3072, 1, E, lds); }
            SYNC();
            rwkv_scan(c, P, lds);
            SYNC();
            rwkv_post(c, P);
            SYNC();
        } else if (l == 1 || l == 2) {
            int base = 0;
            if (l == 1) {
                wprep(c, scr, base, P.in(28), 1024, 3088, 3088, (bf16_t*)(P.ws + R_W + W_MIX1), 1024, 3328, 1024, 0, 0, nullptr, 0);
                wprep(c, scr, base, P.in(32), 1024, 1024, 1024, (bf16_t*)(P.ws + R_W + W_WO), 1024, 1024, 1024, 0, 0, nullptr, 0);
            } else {
                wprep(c, scr, base, P.in(33), 1024, 3072, 3072, (bf16_t*)(P.ws + R_W + W_MIX1), 1024, 3072, 1024, 0, 0, nullptr, 0);
                wprep(c, scr, base, P.in(35), 1024, 1024, 1024, (bf16_t*)(P.ws + R_W + W_WO), 1024, 1024, 1024, 0, 0, nullptr, 0);
            }
            wprep_ffn(c, scr, base, P, l);
            norm_to_xn(c, h, P.in(7) + l * 1024, XN);
            SYNC();
            { pg8::Gemm g{XN, (const bf16_t*)(P.ws + R_W + W_MIX1), 1024, 1024, 1024, NOGRP, 0u};
              pg8::StaticOrder S; S.init(NPROMPT / 256, 12, G, cid);
              if (l == 1) pg8::gl_direct(c.lane, c.gw, c.NGW, XN, g.Bt, (float*)(P.ws + R_BIG + B_GL));
              pg8::Epi<pg8::EP_Z> E{(void*)(P.ws + R_BIG + B_Z), (void*)(P.ws + R_BIG + B_GL), nullptr, nullptr};
              pg8::gemm_phase(c.tid, ldsl, g, S, E); FRESH(); pg8::thin_gemm<pg8::EP_Z, false>(c.lane, c.wave, g, l == 1 ? 3328 : 3072, 1, E, lds); }
            SYNC();
            if (l == 1) { gla_pre(c, P, lds); SYNC(); gla_scan(c, P, lds); SYNC(); gla_post(c, P); }
            else conv_mid(c, P);
            SYNC();
        } else {
            int base = 0;
            for (int gi = 0; gi < 4; ++gi)
                wprep(c, scr, base, P.in(36) + gi * 65536, 256, 256, 256, (bf16_t*)(P.ws + R_W + W_MIX1), 256, 256, 256, gi * 256, 0, P.in(37) + gi * 256, 3);
            wprep_ffn(c, scr, base, P, 3);
            pool_norm(c, P);
            SYNC();
            pool_mid(c, P);
            SYNC();
        }
        { pg8::Gemm g = (l == 3) ? pg8::Gemm{XN, (const bf16_t*)(P.ws + R_W + W_MIX1), 1024, 256, 256, 0, 512u}
                                 : pg8::Gemm{XN, (const bf16_t*)(P.ws + R_W + W_WO), 1024, 1024, 1024, NOGRP, 0u};
          pg8::StaticOrder S; S.init(NPROMPT / 256, 4, G, cid);
          pg8::Epi<pg8::EP_RESI> E{(void*)h, nullptr, (l == 0) ? P.in(0) : nullptr, nullptr};
          pg8::gemm_phase(c.tid, ldsl, g, S, E); FRESH(); pg8::thin_gemm<pg8::EP_RESI, true>(c.lane, c.wave, g, 1024, (l == 3) ? 1 : 4, E, lds); }
        SYNC();
        norm_to_xn(c, h, P.in(8) + l * 1024, XN);
        SYNC();
        { pg8::Gemm g{XN, (const bf16_t*)(P.ws + R_W + W_UP), 1024, 1024, 1024, NOGRP, 0u};
          pg8::StaticOrder S; S.init(NPROMPT / 256, 16, G, cid);
          pg8::Epi<pg8::EP_UP> E{(void*)(P.ws + R_BIG), nullptr, nullptr, nullptr};
          pg8::gemm_phase(c.tid, ldsl, g, S, E); FRESH(); pg8::thin_gemm<pg8::EP_UP, false>(c.lane, c.wave, g, 4096, 1, E, lds); }
        SYNC();
        { pg8::Gemm g{(const bf16_t*)(P.ws + R_BIG), (const bf16_t*)(P.ws + R_W + W_DOWN), 4096, 4096, 4096, NOGRP, 0u};
          pg8::StaticOrder S; S.init(NPROMPT / 256, 4, G, cid);
          pg8::Epi<pg8::EP_RESI> E{(void*)h, nullptr, nullptr, nullptr};
          pg8::gemm_phase(c.tid, ldsl, g, S, E); FRESH(); pg8::thin_gemm<pg8::EP_RESI, true>(c.lane, c.wave, g, 1024, 4, E, lds); }
        SYNC();
    }
    norm_rows<true>(c, h, P.in(9), nullptr, h);
}

extern "C" void kernel_launch(void* const* d_in, const int* in_sizes, int n_in, void* d_out, int out_size, void* d_ws, size_t ws_size, hipStream_t stream) {
    static int grid = 0;
    if (grid == 0) {
        if (n_in != 38 || ws_size < WS_NEED) { fprintf(stderr, "kernel_launch: need 38 inputs and %zu bytes of workspace; got %d, %zu\n", (size_t)WS_NEED, n_in, ws_size); grid = -1; return; }
        int dev = 0, cus = 0, per_cu = 0;
        (void)hipGetDevice(&dev);
        (void)hipDeviceGetAttribute(&cus, hipDeviceAttributeMultiprocessorCount, dev);
        if (hipFuncSetAttribute((const void*)hybrid_fwd, hipFuncAttributeMaxDynamicSharedMemorySize, LDS_BYTES) != hipSuccess) { fprintf(stderr, "kernel_launch: hipFuncSetAttribute failed\n"); grid = -1; return; }
        if (hipOccupancyMaxActiveBlocksPerMultiprocessor(&per_cu, (const void*)hybrid_fwd, 512, LDS_BYTES) != hipSuccess || per_cu < 1) { fprintf(stderr, "kernel_launch: occupancy query failed (%d)\n", per_cu); grid = -1; return; }
        grid = cus;
    }
    if (grid < 0) return;
    Args p{};
    for (int i = 0; i < 38; ++i) p.in[i] = (const float*)d_in[i];
    p.out = (float*)d_out; p.ws = (unsigned char*)d_ws;
    void* args[] = {&p};
    hipError_t e = hipLaunchCooperativeKernel((const void*)hybrid_fwd, dim3(grid), dim3(512), args, LDS_BYTES, stream);
    if (e != hipSuccess) fprintf(stderr, "cooperative launch failed: %s (grid %d)\n", hipGetErrorString(e), grid);
}
```

```cpp
#include <hip/hip_runtime.h>
#include <hip/hip_cooperative_groups.h>
#include <cstdio>
#include <cstdint>
namespace cg = cooperative_groups;

#define LAS __attribute__((address_space(3)))
typedef unsigned short bf16_t;
typedef _Float16 h16;
typedef short bf16x8 __attribute__((ext_vector_type(8)));
typedef float f32x4 __attribute__((ext_vector_type(4)));
typedef float f32x2 __attribute__((ext_vector_type(2)));
typedef unsigned u32x4 __attribute__((ext_vector_type(4)));
typedef unsigned u32x2 __attribute__((ext_vector_type(2)));
typedef _Float16 h16x2 __attribute__((ext_vector_type(2)));
typedef _Float16 h16x4 __attribute__((ext_vector_type(4)));
typedef _Float16 h16x8 __attribute__((ext_vector_type(8)));

constexpr int D = 1024, NPROMPT = 16384, SEQ = 2048, NB = 8, NSB = 128, MREAL = 16512, MP = 16640, DFF = 4096;
constexpr size_t O_Y = 0, O_WKVP = 16908288, O_WKVS = 17432576, O_SHP = 25821184, O_SHS = 25829376, O_GLAP = 25960448, O_GLAS = 27009024,
                 O_CONVP = 43786240, O_CONVS = 43802624, O_POOLP = 44064768, O_POOLS = 44187648;
constexpr size_t W_MIX1 = 0, W_MIX2 = 15728640, W_WO = 17301504, W_UP = 19398656, W_DOWN = 27787264, W_END = 36175872;
constexpr size_t R_W = 0, R_XN = 36700160, R_BIG = R_XN + (size_t)MP * 1024 * 2;
constexpr size_t B_WAG = 0, B_U2 = 0, B_RKV = (size_t)MP * 3072 * 2, B_LH = B_RKV + (size_t)MP * 3072 * 2, B_Y = B_LH + (size_t)MP * 768 * 2, B_END0 = B_Y + (size_t)MP * 1024 * 2;
constexpr size_t B_Z = 0, B_GL = (size_t)MP * 3072 * 2, B_O = B_GL + (size_t)MP * 16 * 4;
constexpr size_t WS_BAR = R_BIG + B_END0;
constexpr size_t WS_NEED = WS_BAR + 16384;
constexpr int LDS_TAB = 155648, LDS_BYTES = 155648 + 512;

struct Args { const float* in[38]; float* out; unsigned char* ws; };
struct Params {
    LAS unsigned long long* tab; float* out; unsigned char* ws;
    __device__ __forceinline__ const float* in(int i) const { const unsigned long long v = tab[i];
        const unsigned lo = __builtin_amdgcn_readfirstlane((unsigned)v), hi = __builtin_amdgcn_readfirstlane((unsigned)(v >> 32));
        return (const float*)(const __attribute__((address_space(1))) float*)(((unsigned long long)hi << 32) | lo); }
};

__device__ __forceinline__ unsigned f2bf(float f) { unsigned u = __builtin_bit_cast(unsigned, f); return (u + 0x7fffu + ((u >> 16) & 1u)) >> 16; }
__device__ __forceinline__ unsigned pk2(float lo, float hi) { return f2bf(lo) | (f2bf(hi) << 16); }
__device__ __forceinline__ u32x2 pk4(f32x4 v) { u32x2 r; r.x = pk2(v[0], v[1]); r.y = pk2(v[2], v[3]); return r; }
__device__ __forceinline__ h16x4 h4(f32x4 v) { h16x4 r; r[0] = (h16)v[0]; r[1] = (h16)v[1]; r[2] = (h16)v[2]; r[3] = (h16)v[3]; return r; }
__device__ __forceinline__ f32x4 f4(h16x4 v) { f32x4 r; r[0] = (float)v[0]; r[1] = (float)v[1]; r[2] = (float)v[2]; r[3] = (float)v[3]; return r; }
template <int CTRL> __device__ __forceinline__ float dppmov(float v) { return __builtin_bit_cast(float, __builtin_amdgcn_update_dpp(0, __builtin_bit_cast(int, v), CTRL, 0xF, 0xF, true)); }
__device__ __forceinline__ float reduce16(float v) {
    v += dppmov<0xB1>(v);
    v += dppmov<0x4E>(v);
    v += dppmov<0x141>(v);
    v += dppmov<0x140>(v);
    return v;
}
__device__ __forceinline__ float wave_sum(float v) {
    v = reduce16(v);
    const int iv = __builtin_bit_cast(int, v);
    const float r0 = __builtin_bit_cast(float, __builtin_amdgcn_readlane(iv, 0)), r1 = __builtin_bit_cast(float, __builtin_amdgcn_readlane(iv, 16));
    const float r2 = __builtin_bit_cast(float, __builtin_amdgcn_readlane(iv, 32)), r3 = __builtin_bit_cast(float, __builtin_amdgcn_readlane(iv, 48));
    return (r0 + r1) + (r2 + r3);
}
__device__ __forceinline__ float fexp(float x) { return __builtin_amdgcn_exp2f(x * 1.4426950408889634f); }
__device__ __forceinline__ float flog(float x) { return __builtin_amdgcn_logf(x) * 0.6931471805599453f; }
__device__ __forceinline__ float sigmoidf_(float x) { return __builtin_amdgcn_rcpf(1.0f + fexp(-x)); }
__device__ __forceinline__ float softplusf_(float x) { return fmaxf(x, 0.f) + flog(1.0f + fexp(-fabsf(x))); }
__device__ __forceinline__ float tanhf_(float x) { return 1.0f - 2.0f * __builtin_amdgcn_rcpf(1.0f + fexp(2.0f * x)); }
#define LDS_WAIT() asm volatile("s_waitcnt lgkmcnt(0)" ::: "memory")
#define LDS_BARRIER() do { asm volatile("s_waitcnt lgkmcnt(0)" ::: "memory"); __builtin_amdgcn_s_barrier(); asm volatile("" ::: "memory"); } while (0)

namespace pg8 {
constexpr int BM = 256, BK = 64, HALF = 128, HTB = HALF * BK * 2, STAGE_BYTES = 8 * HTB, NXCD = 8, WGM = 8;
__host__ __device__ __forceinline__ int lds_byte(int r, int c) { const int st = (r >> 4) * 2 + (c >> 5), rr = r & 15, cc = c & 31, ob = rr * 64 + cc * 2; return st * 1024 + (ob ^ (((ob >> 9) & 1) << 5)); }
__host__ __device__ __forceinline__ void stage_rc(int b, int& R, int& C) { const int st = b / 1024, sb = b % 1024, swz = sb ^ (((sb >> 9) & 1) << 5); R = (st >> 1) * 16 + swz / 64; C = (st & 1) * 32 + (swz % 64) / 2; }
__host__ __device__ __forceinline__ int perm32(int rho) { const int n = rho >> 4, i = rho & 15; return 8 * (i >> 2) + 4 * n + (i & 3); }

__device__ __forceinline__ const char* sgpr_ptr(const char* p) { const unsigned long long v = (unsigned long long)p;
    const unsigned lo = __builtin_amdgcn_readfirstlane((unsigned)v), hi = __builtin_amdgcn_readfirstlane((unsigned)(v >> 32));
    return (const char*)(const __attribute__((address_space(1))) char*)(((unsigned long long)hi << 32) | lo); }
struct Unit { int pm, pn; };
struct Gemm { const bf16_t* A; const bf16_t* Bt; int lda, ldb, K, grp_shift; unsigned a_grp_bytes; };
__device__ __forceinline__ const char* unit_a(const Gemm& g, const Unit& u) { return (const char*)g.A + (size_t)(u.pn >> g.grp_shift) * g.a_grp_bytes + (size_t)u.pm * (size_t)(BM * 2) * (size_t)g.lda; }
__device__ __forceinline__ const char* unit_b(const Gemm& g, const Unit& u) { return (const char*)g.Bt + (size_t)u.pn * (size_t)(BM * 2) * (size_t)g.ldb; }

struct StaticOrder {
    int nM, nN, nwg, G, c;
    __device__ void init(int nM_, int nN_, int G_, int c_) { nM = nM_; nN = nN_; nwg = nM * nN; G = G_; c = c_; }
    __device__ bool next(int i, Unit& u) const {
        const long L = (long)i * G + c; if (L >= nwg) return false;
        int wgid = (int)L; { const int q = nwg / NXCD, r = nwg % NXCD, xcd = wgid % NXCD, off = wgid / NXCD; wgid = (xcd < r ? xcd * (q + 1) : r * (q + 1) + (xcd - r) * q) + off; }
        const int nig = WGM * nN, gid = wgid / nig, fm = gid * WGM, gsz = (nM - fm) < WGM ? (nM - fm) : WGM;
        u.pm = __builtin_amdgcn_readfirstlane(fm + ((wgid % nig) % gsz)); u.pn = __builtin_amdgcn_readfirstlane((wgid % nig) / gsz); return true;
    }
};

template <class Epi>
__device__ __forceinline__ void gemm_phase(const int tid, LAS unsigned char* lds, const Gemm g, const StaticOrder& S, const Epi& E) {
    const int wid = __builtin_amdgcn_readfirstlane(tid >> 6), lane = tid & 63, wr = wid >> 2, wc = wid & 3, fr = lane & 15, fq = lane >> 4;
    const int K = g.K, nt = K / BK;
    unsigned voffA[2], voffB[2];
#pragma unroll
    for (int i = 0; i < 2; ++i) { int R, C; stage_rc(tid * 16 + i * 8192, R, C); const int Rb = Epi::PERM ? ((R & ~31) + perm32(R & 31)) : R;
        voffA[i] = (unsigned)(R * g.lda + C) * 2u; voffB[i] = (unsigned)(Rb * g.ldb + C) * 2u; }
    const size_t kstep = (size_t)(BK * 2);
    const size_t hstepA = (size_t)HALF * g.lda * 2, hstepB = (size_t)HALF * g.ldb * 2;
    const unsigned ldsw = (unsigned)wid * 1024u;
    const int aoff = lds_byte(wr * 64 + fr, fq * 8), boff = lds_byte(wc * 32 + fr, fq * 8);
#define PG8_SA(b, h) (((b) * 2 + (h)) * HTB)
#define PG8_SB(b, h) ((4 + (b) * 2 + (h)) * HTB)
#define PG8_STAGE(bufoff, gbase, voff) do { const char* gb_ = sgpr_ptr(gbase); _Pragma("unroll") for (int _i = 0; _i < 2; ++_i) \
        __builtin_amdgcn_global_load_lds((const unsigned*)(gb_ + (voff)[_i]), (LAS unsigned*)(lds + (bufoff) + ldsw + _i * 8192), 16, 0, 0); } while (0)
#define PG8_LDA(dst, b, h) do { _Pragma("unroll") for (int m = 0; m < 4; ++m) _Pragma("unroll") for (int k = 0; k < 2; ++k) dst[m][k] = *(const LAS bf16x8*)(lds + PG8_SA(b, h) + aoff + m * 2048 + k * 1024); } while (0)
#define PG8_LDB(dst, b, h) do { _Pragma("unroll") for (int n = 0; n < 2; ++n) _Pragma("unroll") for (int k = 0; k < 2; ++k) dst[n][k] = *(const LAS bf16x8*)(lds + PG8_SB(b, h) + boff + n * 2048 + k * 1024); } while (0)
#define PG8_MMA(ai, bj, At, Bt) do { __builtin_amdgcn_s_setprio(1); _Pragma("unroll") for (int m = 0; m < 4; ++m) _Pragma("unroll") for (int n = 0; n < 2; ++n) _Pragma("unroll") for (int k = 0; k < 2; ++k) \
        acc[ai][bj][m][n] = __builtin_amdgcn_mfma_f32_16x16x32_bf16(Bt[n][k], At[m][k], acc[ai][bj][m][n], 0, 0, 0); __builtin_amdgcn_s_setprio(0); } while (0)
#define PG8_WAIT_V(n) asm volatile("s_waitcnt vmcnt(" #n ")" ::: "memory")
#define PG8_WAIT_L(n) asm volatile("s_waitcnt lgkmcnt(" #n ")" ::: "memory")
#define PG8_BAR __builtin_amdgcn_s_barrier()
#define PG8_SCHED __builtin_amdgcn_sched_barrier(0)
    Unit cur, nxt; int ui = 0;
    if (!S.next(0, cur)) return;
    f32x4 acc[2][2][4][2];
    if constexpr (Epi::INIT) E.init(acc, cur, wr, wc, fr, fq);
    else {
#pragma unroll
    for (int a = 0; a < 2; ++a)
#pragma unroll
        for (int b = 0; b < 2; ++b)
#pragma unroll
            for (int m = 0; m < 4; ++m)
#pragma unroll
                for (int n = 0; n < 2; ++n) acc[a][b][m][n] = (f32x4){0.f, 0.f, 0.f, 0.f};
    }
    bf16x8 At[4][2], B0[2][2], B1[2][2];
    const char* cA = unit_a(g, cur); const char* cB = unit_b(g, cur);
    PG8_STAGE(PG8_SB(0, 0), cB, voffB); PG8_STAGE(PG8_SB(0, 1), cB + hstepB, voffB); PG8_STAGE(PG8_SA(0, 0), cA, voffA); PG8_STAGE(PG8_SA(0, 1), cA + hstepA, voffA);
    if (wr == 1) PG8_BAR;
    PG8_WAIT_V(2); PG8_BAR;
    PG8_STAGE(PG8_SB(1, 0), cB + kstep, voffB); PG8_STAGE(PG8_SA(1, 0), cA + kstep, voffA); PG8_STAGE(PG8_SB(1, 1), cB + hstepB + kstep, voffB);
    PG8_WAIT_V(6); PG8_BAR;
    for (;;) {
        const bool has_next = S.next(ui + 1, nxt);
        const char* nA = has_next ? unit_a(g, nxt) : cA; const char* nB = has_next ? unit_b(g, nxt) : cB;
        for (int t = 0; t < nt; t += 2) {
            const bool last = (t == nt - 2);
            const char* a1 = cA + (size_t)(t + 1) * kstep;
            const char* a2 = last ? nA : cA + (size_t)(t + 2) * kstep; const char* b2 = last ? nB : cB + (size_t)(t + 2) * kstep;
            const char* a3 = a2 + kstep; const char* b3 = b2 + kstep;
            PG8_LDB(B0, 0, 0); PG8_LDB(B1, 0, 1); PG8_SCHED; PG8_LDA(At, 0, 0); PG8_STAGE(PG8_SA(1, 1), a1 + hstepA, voffA);
            PG8_WAIT_V(8); PG8_WAIT_L(0); PG8_BAR; PG8_MMA(0, 0, At, B0); PG8_MMA(0, 1, At, B1); PG8_BAR; PG8_SCHED;
            PG8_LDA(At, 0, 1); PG8_STAGE(PG8_SB(0, 0), b2, voffB); PG8_STAGE(PG8_SB(0, 1), b2 + hstepB, voffB); PG8_STAGE(PG8_SA(0, 0), a2, voffA);
            PG8_WAIT_V(8); PG8_WAIT_L(0); PG8_BAR; PG8_MMA(1, 0, At, B0); PG8_MMA(1, 1, At, B1); PG8_BAR; PG8_SCHED;
            PG8_LDB(B0, 1, 0); PG8_LDB(B1, 1, 1); PG8_SCHED; PG8_LDA(At, 1, 0); PG8_STAGE(PG8_SA(0, 1), a2 + hstepA, voffA);
            PG8_WAIT_V(8); PG8_WAIT_L(0); PG8_BAR; PG8_MMA(0, 0, At, B0); PG8_MMA(0, 1, At, B1); PG8_BAR; PG8_SCHED;
            PG8_LDA(At, 1, 1); PG8_STAGE(PG8_SB(1, 0), b3, voffB); PG8_STAGE(PG8_SB(1, 1), b3 + hstepB, voffB); PG8_STAGE(PG8_SA(1, 0), a3, voffA);
            PG8_WAIT_V(8); PG8_WAIT_L(0); PG8_BAR; PG8_MMA(1, 0, At, B0); PG8_MMA(1, 1, At, B1); PG8_BAR; PG8_SCHED;
        }
        if (wr == 0) PG8_BAR;
        E(acc, cur, wr, wc, fr, fq);
        if (!has_next) break;
        if constexpr (Epi::INIT) E.init(acc, nxt, wr, wc, fr, fq);
        else {
#pragma unroll
        for (int a = 0; a < 2; ++a)
#pragma unroll
            for (int b = 0; b < 2; ++b)
#pragma unroll
                for (int m = 0; m < 4; ++m)
#pragma unroll
                    for (int n = 0; n < 2; ++n) acc[a][b][m][n] = (f32x4){0.f, 0.f, 0.f, 0.f};
        }
        cur = nxt; cA = nA; cB = nB; ++ui;
        if (wr == 1) PG8_BAR;
    }
    PG8_WAIT_V(0);
    PG8_BAR;
#undef PG8_SA
#undef PG8_SB
#undef PG8_STAGE
#undef PG8_LDA
#undef PG8_LDB
#undef PG8_MMA
#undef PG8_WAIT_V
#undef PG8_WAIT_L
#undef PG8_BAR
#undef PG8_SCHED
}

enum { EP_RKV = 0, EP_LORA2 = 1, EP_RES = 2, EP_UP = 3, EP_Z = 4, EP_RESI = 5 };
template <int MODE> struct Epi {
    static constexpr bool PERM = (MODE != EP_RES && MODE != EP_RESI), INIT = (MODE == EP_RESI);
    void* o0; void* o1; const float* p0; const float* p1;
    template <bool ATOMIC> __device__ __forceinline__ void put(int row, int col, f32x4 v) const {
        const int pn = col >> 8;
        if constexpr (MODE == EP_RKV) {
            if (pn < 12) { *(h16x4*)((h16*)o0 + (size_t)row * 3072 + col) = h4(v); }
            else {
                if (pn == 12) { v[0] = tanhf_(v[0]); v[1] = tanhf_(v[1]); v[2] = tanhf_(v[2]); v[3] = tanhf_(v[3]); }
                else if (pn == 14) { v[0] = sigmoidf_(v[0]); v[1] = sigmoidf_(v[1]); v[2] = sigmoidf_(v[2]); v[3] = sigmoidf_(v[3]); }
                *(u32x2*)((bf16_t*)o1 + (size_t)row * 768 + (col - 3072)) = pk4(v);
            }
        } else if constexpr (MODE == EP_LORA2) {
            const int grp = pn >> 2, c1 = col & 1023;
            if (grp == 0) { const f32x4 b = *(const f32x4*)(p0 + c1);
#pragma unroll
                for (int j = 0; j < 4; ++j) { const float x = b[j] + v[j]; const float wl = -softplusf_(-x) - 0.5f; v[j] = -fexp(wl); } }
            else if (grp == 1) { const f32x4 b = *(const f32x4*)(p1 + c1);
#pragma unroll
                for (int j = 0; j < 4; ++j) v[j] = sigmoidf_(b[j] + v[j]); }
            *(h16x4*)((h16*)o0 + (size_t)row * 3072 + col) = h4(v);
        } else if constexpr (MODE == EP_RES || MODE == EP_RESI) {
            float* hp = (float*)o0 + (size_t)row * 1024 + col;
            if constexpr (MODE == EP_RES) { if (p0) v = v * *(const f32x4*)(p0 + col); }
            if constexpr (ATOMIC) {
#pragma unroll
                for (int j = 0; j < 4; ++j) (void)__hip_atomic_fetch_add(hp + j, v[j], __ATOMIC_RELAXED, __HIP_MEMORY_SCOPE_AGENT);
            } else *(f32x4*)hp = *(const f32x4*)hp + v;
        } else if constexpr (MODE == EP_UP) {
#pragma unroll
            for (int j = 0; j < 4; ++j) { const float r = fmaxf(v[j], 0.f); v[j] = r * r; }
            *(u32x2*)((bf16_t*)o0 + (size_t)row * 4096 + col) = pk4(v);
        } else {
            if (pn < 12) { *(h16x4*)((h16*)o0 + (size_t)row * 3072 + col) = h4(v); }
            else { const int c = col - 3072; if (c < 16) *(f32x4*)((float*)o1 + (size_t)row * 16 + c) = v; }
        }
    }
    __device__ __forceinline__ void init(f32x4 (&acc)[2][2][4][2], const Unit& u, int wr, int wc, int fr, int fq) const {
        const int rowb = u.pm * BM + wr * 64 + fr, colb = u.pn * BM + wc * 32 + 4 * fq;
#pragma unroll
        for (int ai = 0; ai < 2; ++ai)
#pragma unroll
            for (int m = 0; m < 4; ++m) {
                const float* hrow = (p0 ? p0 : (const float*)o0) + (size_t)(rowb + ai * HALF + m * 16) * 1024 + colb;
#pragma unroll
                for (int bj = 0; bj < 2; ++bj)
#pragma unroll
                    for (int n = 0; n < 2; ++n) acc[ai][bj][m][n] = *(const f32x4*)(hrow + bj * HALF + 16 * n);
            }
    }
    __device__ __forceinline__ void operator()(const f32x4 (&acc)[2][2][4][2], const Unit& u, int wr, int wc, int fr, int fq) const {
        { unsigned ones_ = ~0u; asm volatile("" : "+s"(ones_));
          const int l_ = (int)__builtin_amdgcn_mbcnt_hi(ones_, __builtin_amdgcn_mbcnt_lo(ones_, 0u)); fr = l_ & 15; fq = l_ >> 4; }
        const int rowb = u.pm * BM + wr * 64 + fr;
        const int colb = u.pn * BM + wc * 32 + (PERM ? 8 * fq : 4 * fq);
        if constexpr (MODE == EP_RESI) {
#pragma unroll
            for (int ai = 0; ai < 2; ++ai)
#pragma unroll
                for (int m = 0; m < 4; ++m) {
                    float* hrow = (float*)o0 + (size_t)(rowb + ai * HALF + m * 16) * 1024 + colb;
#pragma unroll
                    for (int bj = 0; bj < 2; ++bj)
#pragma unroll
                        for (int n = 0; n < 2; ++n) *(f32x4*)(hrow + bj * HALF + 16 * n) = acc[ai][bj][m][n];
                }
        } else if constexpr (MODE == EP_RES) {
            f32x4 sc[2][2];
#pragma unroll
            for (int bj = 0; bj < 2; ++bj)
#pragma unroll
                for (int n = 0; n < 2; ++n) sc[bj][n] = p0 ? *(const f32x4*)(p0 + colb + bj * HALF + 16 * n) : (f32x4){1.f, 1.f, 1.f, 1.f};
#pragma unroll
            for (int ai = 0; ai < 2; ++ai)
#pragma unroll
                for (int m = 0; m < 4; ++m) {
                    float* hrow = (float*)o0 + (size_t)(rowb + ai * HALF + m * 16) * 1024 + colb;
                    f32x4 hv[2][2];
#pragma unroll
                    for (int bj = 0; bj < 2; ++bj)
#pragma unroll
                        for (int n = 0; n < 2; ++n) hv[bj][n] = *(const f32x4*)(hrow + bj * HALF + 16 * n);
#pragma unroll
                    for (int bj = 0; bj < 2; ++bj)
#pragma unroll
                        for (int n = 0; n < 2; ++n) *(f32x4*)(hrow + bj * HALF + 16 * n) = hv[bj][n] + acc[ai][bj][m][n] * sc[bj][n];
                }
        } else if constexpr (MODE == EP_LORA2) {
            const int grp = u.pn >> 2;
            const float* bp = (grp == 0) ? p0 : p1;
#pragma unroll
            for (int ai = 0; ai < 2; ++ai)
#pragma unroll
                for (int m = 0; m < 4; ++m) {
                    const int row = rowb + ai * HALF + m * 16;
                    f32x4 bias[2][2];
#pragma unroll
                    for (int bj = 0; bj < 2; ++bj)
#pragma unroll
                        for (int n = 0; n < 2; ++n) bias[bj][n] = (grp < 2) ? *(const f32x4*)(bp + ((colb + bj * HALF + 4 * n) & 1023)) : (f32x4){0.f, 0.f, 0.f, 0.f};
#pragma unroll
                    for (int bj = 0; bj < 2; ++bj)
#pragma unroll
                        for (int n = 0; n < 2; ++n) {
                            f32x4 v = acc[ai][bj][m][n] + bias[bj][n];
                            if (grp == 0) {
#pragma unroll
                                for (int j = 0; j < 4; ++j) { const float wl = -softplusf_(-v[j]) - 0.5f; v[j] = -fexp(wl); } }
                            else if (grp == 1) {
#pragma unroll
                                for (int j = 0; j < 4; ++j) v[j] = sigmoidf_(v[j]); }
                            *(h16x4*)((h16*)o0 + (size_t)row * 3072 + colb + bj * HALF + 4 * n) = h4(v);
                        }
                }
        } else if constexpr (MODE == EP_UP) {
#pragma unroll
            for (int ai = 0; ai < 2; ++ai)
#pragma unroll
                for (int m = 0; m < 4; ++m) {
                    bf16_t* orow = (bf16_t*)o0 + (size_t)(rowb + ai * HALF + m * 16) * 4096 + colb;
#pragma unroll
                    for (int bj = 0; bj < 2; ++bj) {
                        f32x4 v0 = acc[ai][bj][m][0], v1 = acc[ai][bj][m][1];
#pragma unroll
                        for (int j = 0; j < 4; ++j) { const float r0 = fmaxf(v0[j], 0.f), r1 = fmaxf(v1[j], 0.f); v0[j] = r0 * r0; v1[j] = r1 * r1; }
                        *(u32x4*)(orow + bj * HALF) = (u32x4){pk2(v0[0], v0[1]), pk2(v0[2], v0[3]), pk2(v1[0], v1[1]), pk2(v1[2], v1[3])};
                    }
                }
        } else if constexpr (MODE == EP_Z || MODE == EP_RKV) {
            if (u.pn < 12) {
#pragma unroll
                for (int ai = 0; ai < 2; ++ai)
#pragma unroll
                    for (int m = 0; m < 4; ++m) {
                        h16* orow = (h16*)o0 + (size_t)(rowb + ai * HALF + m * 16) * 3072 + colb;
#pragma unroll
                        for (int bj = 0; bj < 2; ++bj) {
                            const f32x4 v0 = acc[ai][bj][m][0], v1 = acc[ai][bj][m][1];
                            h16x8 o; o[0] = (h16)v0[0]; o[1] = (h16)v0[1]; o[2] = (h16)v0[2]; o[3] = (h16)v0[3]; o[4] = (h16)v1[0]; o[5] = (h16)v1[1]; o[6] = (h16)v1[2]; o[7] = (h16)v1[3];
                            *(h16x8*)(orow + bj * HALF) = o;
                        }
                    }
            } else {
#pragma unroll
                for (int ai = 0; ai < 2; ++ai)
#pragma unroll
                    for (int m = 0; m < 4; ++m) {
                        const int row = rowb + ai * HALF + m * 16;
#pragma unroll
                        for (int bj = 0; bj < 2; ++bj)
#pragma unroll
                            for (int n = 0; n < 2; ++n) put<false>(row, colb + bj * HALF + 4 * n, acc[ai][bj][m][n]);
                    }
            }
        } else {
#pragma unroll
            for (int ai = 0; ai < 2; ++ai)
#pragma unroll
                for (int m = 0; m < 4; ++m) {
                    const int row = rowb + ai * HALF + m * 16;
#pragma unroll
                    for (int bj = 0; bj < 2; ++bj)
#pragma unroll
                        for (int n = 0; n < 2; ++n) put<false>(row, colb + bj * HALF + (PERM ? 4 * n : 16 * n), acc[ai][bj][m][n]);
                }
        }
    }
};
template <int MODE, bool ATOMIC>
__device__ __forceinline__ void thin_gemm(int lane, int wave, const Gemm g, int N, int ksplit, const Epi<MODE>& E, unsigned char* ldsb) {
    const int ntn = N >> 4, ntasks = ntn * ksplit, kl = g.K / ksplit, kw = kl >> 3, ns = kw >> 5;
    const int fr = lane & 15, fq = lane >> 4;
    f32x4* red = (f32x4*)ldsb;
    for (int task = blockIdx.x; task < ntasks; task += gridDim.x) {
        const int nt = task % ntn, ks = task / ntn, n0 = nt * 16, k0 = ks * kl + wave * kw;
        const bf16_t* ap = (const bf16_t*)((const char*)g.A + (size_t)((n0 >> 8) >> g.grp_shift) * g.a_grp_bytes) + (size_t)(NPROMPT + fr) * g.lda + k0 + fq * 8;
        const bf16_t* bp = g.Bt + (size_t)(n0 + fr) * g.ldb + k0 + fq * 8;
        const size_t tstride = (size_t)16 * g.lda;
        f32x4 acc[8];
#pragma unroll
        for (int mt = 0; mt < 8; ++mt) acc[mt] = (f32x4){0.f, 0.f, 0.f, 0.f};
        for (int s = 0; s < ns; s += 2) {
            const bool two = (s + 1 < ns);
            bf16x8 b0, b1, a0[8], a1[8];
            b0 = *(const bf16x8*)(bp + 32 * s);
#pragma unroll
            for (int mt = 0; mt < 8; ++mt) a0[mt] = *(const bf16x8*)(ap + mt * tstride + 32 * s);
            if (two) { b1 = *(const bf16x8*)(bp + 32 * s + 32);
#pragma unroll
                for (int mt = 0; mt < 8; ++mt) a1[mt] = *(const bf16x8*)(ap + mt * tstride + 32 * s + 32); }
#pragma unroll
            for (int mt = 0; mt < 8; ++mt) acc[mt] = __builtin_amdgcn_mfma_f32_16x16x32_bf16(b0, a0[mt], acc[mt], 0, 0, 0);
            if (two) {
#pragma unroll
                for (int mt = 0; mt < 8; ++mt) acc[mt] = __builtin_amdgcn_mfma_f32_16x16x32_bf16(b1, a1[mt], acc[mt], 0, 0, 0); }
        }
        __syncthreads();
#pragma unroll
        for (int mt = 0; mt < 8; ++mt) red[(wave * 8 + mt) * 64 + lane] = acc[mt];
        __syncthreads();
        f32x4 sum = red[(0 * 8 + wave) * 64 + lane];
#pragma unroll
        for (int w = 1; w < 8; ++w) sum += red[(w * 8 + wave) * 64 + lane];
        E.template put<ATOMIC>(NPROMPT + wave * 16 + fr, n0 + fq * 4, sum);
    }
}
__device__ __forceinline__ void gl_direct(int lane, int gw, int NGW, const bf16_t* XN, const bf16_t* Bt, float* GL) {
    const int fr = lane & 15, fq = lane >> 4;
    const bf16_t* bp = Bt + (size_t)(3072 + fr) * 1024 + fq * 8;
    for (int mt = gw; mt < NPROMPT / 16; mt += NGW) {
        const bf16_t* ap = XN + (size_t)(mt * 16 + fr) * 1024 + fq * 8;
        f32x4 acc = (f32x4){0.f, 0.f, 0.f, 0.f};
        for (int kk = 0; kk < 1024; kk += 256) {
            bf16x8 a[8], b[8];
#pragma unroll
            for (int i = 0; i < 8; ++i) { a[i] = *(const bf16x8*)(ap + kk + 32 * i); b[i] = *(const bf16x8*)(bp + kk + 32 * i); }
#pragma unroll
            for (int i = 0; i < 8; ++i) acc = __builtin_amdgcn_mfma_f32_16x16x32_bf16(b[i], a[i], acc, 0, 0, 0);
        }
        *(f32x4*)(GL + (size_t)(mt * 16 + fr) * 16 + fq * 4) = acc;
    }
}
}

struct Ctx { int tid, lane, wave, gw, NGW; };

__device__ __forceinline__ void wprep(const Ctx& c, LAS float* scr, int& base, const float* src, int Ks, int Ns, int lsrc, bf16_t* dst, int Kd, int Nd, int ldd, int roff, int coff, const float* mu, int mode) {
    const int nblk = Nd / 32, nitems = (Kd / 64) * nblk;
    int first = (c.gw - (base % c.NGW) + c.NGW) % c.NGW;
    base += nitems;
    const int lane = c.lane;
    for (int it = first; it < nitems; it += c.NGW) {
        const int kb = it / nblk, nb = it % nblk, k0 = 64 * kb, n0 = 32 * nb;
        const int kr = lane >> 3, n4 = (lane & 7) * 4, n = n0 + n4;
        f32x4 v[8];
#pragma unroll
        for (int i = 0; i < 8; ++i) {
            const int k = k0 + kr + 8 * i;
            v[i] = (f32x4){0.f, 0.f, 0.f, 0.f};
            if (k < Ks && n < Ns) { v[i] = *(const f32x4*)(src + (size_t)k * lsrc + n); if (mode == 1) v[i] = v[i] * mu[k]; else if (mode == 2) v[i] = v[i] * (1.0f - mu[k]); else if (mode == 3) v[i] = v[i] * *(const f32x4*)(mu + n); }
        }
#pragma unroll
        for (int i = 0; i < 8; ++i) { LAS float* d = scr + (kr + 8 * i) * 33 + n4; d[0] = v[i][0]; d[1] = v[i][1]; d[2] = v[i][2]; d[3] = v[i][3]; }
        LDS_WAIT();
        const int cc = lane & 7;
#pragma unroll
        for (int j = 0; j < 4; ++j) { const int nn = (lane >> 3) + 8 * j; const LAS float* s = scr + (8 * cc) * 33 + nn;
            u32x4 o; o.x = pk2(s[0 * 33], s[1 * 33]); o.y = pk2(s[2 * 33], s[3 * 33]); o.z = pk2(s[4 * 33], s[5 * 33]); o.w = pk2(s[6 * 33], s[7 * 33]);
            *(u32x4*)(dst + (size_t)(roff + n0 + nn) * ldd + coff + k0 + 8 * cc) = o; }
        LDS_WAIT();
    }
}
__device__ __forceinline__ void wprep_ffn(const Ctx& c, LAS float* scr, int& base, const Params& P, int l) {
    wprep(c, scr, base, P.in(10) + (size_t)l * 4194304, 1024, 4096, 4096, (bf16_t*)(P.ws + R_W + W_UP), 1024, 4096, 1024, 0, 0, nullptr, 0);
    wprep(c, scr, base, P.in(11) + (size_t)l * 4194304, 4096, 1024, 1024, (bf16_t*)(P.ws + R_W + W_DOWN), 4096, 1024, 4096, 0, 0, nullptr, 0);
}

__device__ __forceinline__ float load_row_rstd(const float* xr, int lane, f32x4 (&v)[4], float eps) {
    float s = 0.f;
#pragma unroll
    for (int j = 0; j < 4; ++j) { v[j] = *(const f32x4*)(xr + lane * 4 + 256 * j); s += (v[j][0] * v[j][0] + v[j][1] * v[j][1]) + (v[j][2] * v[j][2] + v[j][3] * v[j][3]); }
    return 1.0f / sqrtf(wave_sum(s) * (1.0f / 1024.0f) + eps);
}

template <bool TOF32, bool NT = false>
__device__ __forceinline__ void norm_rows(const Ctx& c, const float* h, const float* g, bf16_t* XN, float* F32) {
    f32x4 v[4], vn[4], gg[4];
#pragma unroll
    for (int j = 0; j < 4; ++j) gg[j] = *(const f32x4*)(g + c.lane * 4 + 256 * j);
    int m = c.gw;
    if (m < MREAL) {
#pragma unroll
        for (int j = 0; j < 4; ++j) v[j] = *(const f32x4*)(h + (size_t)m * 1024 + c.lane * 4 + 256 * j); }
    while (m < MREAL) {
        const int mn = m + c.NGW;
        if (mn < MREAL) {
#pragma unroll
            for (int j = 0; j < 4; ++j) vn[j] = *(const f32x4*)(h + (size_t)mn * 1024 + c.lane * 4 + 256 * j); }
        float ssq = 0.f;
#pragma unroll
        for (int j = 0; j < 4; ++j) ssq += (v[j][0] * v[j][0] + v[j][1] * v[j][1]) + (v[j][2] * v[j][2] + v[j][3] * v[j][3]);
        const float rstd = 1.0f / sqrtf(wave_sum(ssq) * (1.0f / 1024.0f) + 1e-6f);
#pragma unroll
        for (int j = 0; j < 4; ++j) {
            const f32x4 y = v[j] * rstd * gg[j];
            if constexpr (TOF32 && NT) __builtin_nontemporal_store(y, (f32x4*)(F32 + (size_t)m * 1024 + c.lane * 4 + 256 * j));
            else if constexpr (TOF32) *(f32x4*)(F32 + (size_t)m * 1024 + c.lane * 4 + 256 * j) = y;
            else *(u32x2*)(XN + (size_t)m * 1024 + c.lane * 4 + 256 * j) = pk4(y);
        }
#pragma unroll
        for (int j = 0; j < 4; ++j) v[j] = vn[j];
        m = mn;
    }
}
__device__ __forceinline__ void norm_to_xn(const Ctx& c, const float* h, const float* g, bf16_t* XN) { norm_rows<false>(c, h, g, XN, nullptr); }

__device__ __forceinline__ void rwkv_prep(const Ctx& c, const Params& P) {
    float* h = P.out; bf16_t* U2 = (bf16_t*)(P.ws + R_BIG + B_U2);
    const float* g = P.in(7); const float* xp = P.in(0); const float* xs = P.in(1); const float* shs = P.in(3);
    f32x4 v[4], vn[4], gg[4];
#pragma unroll
    for (int j = 0; j < 4; ++j) gg[j] = *(const f32x4*)(g + c.lane * 4 + 256 * j);
    int m = c.gw;
    if (m < MREAL) { const float* xr = m < NPROMPT ? xp + (size_t)m * 1024 : xs + (size_t)(m - NPROMPT) * 1024;
#pragma unroll
        for (int j = 0; j < 4; ++j) v[j] = *(const f32x4*)(xr + c.lane * 4 + 256 * j); }
    while (m < MREAL) {
        const int mn = m + c.NGW;
        if (mn < MREAL) { const float* xr = mn < NPROMPT ? xp + (size_t)mn * 1024 : xs + (size_t)(mn - NPROMPT) * 1024;
#pragma unroll
            for (int j = 0; j < 4; ++j) vn[j] = *(const f32x4*)(xr + c.lane * 4 + 256 * j); }
        bf16_t* u2 = U2 + (size_t)m * 2048 + c.lane * 4;
        float ssq = 0.f;
#pragma unroll
        for (int j = 0; j < 4; ++j) ssq += (v[j][0] * v[j][0] + v[j][1] * v[j][1]) + (v[j][2] * v[j][2] + v[j][3] * v[j][3]);
        const float rstd = 1.0f / sqrtf(wave_sum(ssq) * (1.0f / 1024.0f) + 1e-6f);
#pragma unroll
        for (int j = 0; j < 4; ++j) {
            const int col = c.lane * 4 + 256 * j;
            if (m >= NPROMPT) *(f32x4*)(h + (size_t)m * 1024 + col) = v[j];
            const f32x4 u = v[j] * rstd * gg[j];
            const u32x2 ub = pk4(u);
            *(u32x2*)(u2 + 256 * j) = ub;
            if (m < NPROMPT) {
                const int t = m & 2047, b = m >> 11;
                if (t < 2047) *(u32x2*)(u2 + 2048 + 1024 + 256 * j) = ub; else *(f32x4*)(P.out + O_SHP + (size_t)b * 1024 + col) = u;
                if (t == 0) *(u32x2*)(u2 + 1024 + 256 * j) = pk4(u * 0.0f);
            } else {
                const int b = m - NPROMPT;
                *(u32x2*)(u2 + 1024 + 256 * j) = pk4(*(const f32x4*)(shs + (size_t)b * 1024 + col));
                *(f32x4*)(P.out + O_SHS + (size_t)b * 1024 + col) = u;
            }
        }
#pragma unroll
        for (int j = 0; j < 4; ++j) v[j] = vn[j];
        m = mn;
    }
}
__device__ __forceinline__ void rwkv_wprep(const Ctx& c, LAS float* scr, const Params& P) {
    int base = 0;
    bf16_t* B1 = (bf16_t*)(P.ws + R_W + W_MIX1); bf16_t* B2 = (bf16_t*)(P.ws + R_W + W_MIX2);
    const float* mu = P.in(12);
    wprep(c, scr, base, P.in(13) + 0 * 1048576, 1024, 1024, 1024, B1, 1024, 1024, 2048, 0, 0, mu + 0 * 1024, 2);
    wprep(c, scr, base, P.in(13) + 0 * 1048576, 1024, 1024, 1024, B1, 1024, 1024, 2048, 0, 1024, mu + 0 * 1024, 1);
    wprep(c, scr, base, P.in(13) + 1 * 1048576, 1024, 1024, 1024, B1, 1024, 1024, 2048, 1024, 0, mu + 2 * 1024, 2);
    wprep(c, scr, base, P.in(13) + 1 * 1048576, 1024, 1024, 1024, B1, 1024, 1024, 2048, 1024, 1024, mu + 2 * 1024, 1);
    wprep(c, scr, base, P.in(13) + 2 * 1048576, 1024, 1024, 1024, B1, 1024, 1024, 2048, 2048, 0, mu + 3 * 1024, 2);
    wprep(c, scr, base, P.in(13) + 2 * 1048576, 1024, 1024, 1024, B1, 1024, 1024, 2048, 2048, 1024, mu + 3 * 1024, 1);
    wprep(c, scr, base, P.in(15), 1024, 64, 64, B1, 1024, 256, 2048, 3072, 0, mu + 1 * 1024, 2);
    wprep(c, scr, base, P.in(15), 1024, 64, 64, B1, 1024, 256, 2048, 3072, 1024, mu + 1 * 1024, 1);
    wprep(c, scr, base, P.in(18), 1024, 64, 64, B1, 1024, 256, 2048, 3328, 0, mu + 4 * 1024, 2);
    wprep(c, scr, base, P.in(18), 1024, 64, 64, B1, 1024, 256, 2048, 3328, 1024, mu + 4 * 1024, 1);
    wprep(c, scr, base, P.in(20), 1024, 160, 160, B1, 1024, 256, 2048, 3584, 0, mu + 5 * 1024, 2);
    wprep(c, scr, base, P.in(20), 1024, 160, 160, B1, 1024, 256, 2048, 3584, 1024, mu + 5 * 1024, 1);
    wprep(c, scr, base, P.in(16), 64, 1024, 1024, B2, 256, 1024, 256, 0, 0, nullptr, 0);
    wprep(c, scr, base, P.in(19), 64, 1024, 1024, B2, 256, 1024, 256, 1024, 0, nullptr, 0);
    wprep(c, scr, base, P.in(21), 160, 1024, 1024, B2, 256, 1024, 256, 2048, 0, nullptr, 0);
    wprep(c, scr, base, P.in(27), 1024, 1024, 1024, (bf16_t*)(P.ws + R_W + W_WO), 1024, 1024, 1024, 0, 0, nullptr, 0);
    wprep_ffn(c, scr, base, P, 0);
}

struct RwkvVec { f32x4 r, w, k, na, b; };
__device__ __forceinline__ RwkvVec rwkv_derive(const Params& P, f32x4 r, f32x4 k, f32x4 wl, f32x4 a, int c4) {
    const f32x4 kk0 = k * *(const f32x4*)(P.in(22) + c4);
    const float ss = reduce16((kk0[0] * kk0[0] + kk0[1] * kk0[1]) + (kk0[2] * kk0[2] + kk0[3] * kk0[3]));
    const float inv = 1.0f / fmaxf(sqrtf(ss), 1e-12f);
    const f32x4 kk = kk0 * inv;
    const f32x4 ka = *(const f32x4*)(P.in(23) + c4);
    RwkvVec o;
    o.r = r;
    o.k = k * (1.0f + (a - 1.0f) * ka);
    o.b = kk * a;
    o.na = -kk;
#pragma unroll
    for (int j = 0; j < 4; ++j) o.w[j] = fexp(wl[j]);
    return o;
}

__device__ __forceinline__ float reduce8(float v) {
    v += dppmov<0xB1>(v); v += dppmov<0x4E>(v); v += dppmov<0x141>(v); return v;
}
__device__ __forceinline__ void rwkv_scan(const Ctx& c, const Params& P, unsigned char* ldsb) {
    const h16* RKV = (const h16*)(P.ws + R_BIG + B_RKV); const h16* WAG = (const h16*)(P.ws + R_BIG + B_WAG); h16* Y = (h16*)(P.ws + R_BIG + B_Y);
    constexpr int T = 32, NC = SEQ / T;
    constexpr int BUF_FLOATS = 5 * T * 64 + T * 32, YP_FLOATS = T * 32 * 8;
    float* L = (float*)ldsb;
    float* YpB = L + 2 * BUF_FLOATS;
    const int tid = c.tid, lane = c.lane, wave = c.wave;
    const int rr = (wave & 3) * 8 + (lane >> 3), kq = lane & 7;
    const int t2 = tid & 255, pt = t2 >> 4, pc = (t2 & 15) * 4;
    for (int task = blockIdx.x; task < 256; task += gridDim.x) {
        const int chain = task >> 1, half = task & 1, b = chain >> 4, hd = chain & 15;
        const int vrow = half * 32 + rr;
        const int c4 = hd * 64 + pc;
        f32x4 S0 = (f32x4){0.f, 0.f, 0.f, 0.f}, S1 = S0;
        h16x4 pr0, pk0, pv0, pw0, pa0, pr1, pk1, pv1, pw1, pa1;
        const f32x4 kkw = *(const f32x4*)(P.in(22) + c4), kaw = *(const f32x4*)(P.in(23) + c4);
#define RW_ISSUE(ch) do { const size_t m_ = (size_t)b * SEQ + (ch) * T + pt; \
            pr0 = *(const h16x4*)(RKV + m_ * 3072 + c4); pk0 = *(const h16x4*)(RKV + m_ * 3072 + 1024 + c4); pv0 = *(const h16x4*)(RKV + m_ * 3072 + 2048 + c4); \
            pw0 = *(const h16x4*)(WAG + m_ * 3072 + c4); pa0 = *(const h16x4*)(WAG + m_ * 3072 + 1024 + c4); \
            pr1 = *(const h16x4*)(RKV + (m_ + 16) * 3072 + c4); pk1 = *(const h16x4*)(RKV + (m_ + 16) * 3072 + 1024 + c4); pv1 = *(const h16x4*)(RKV + (m_ + 16) * 3072 + 2048 + c4); \
            pw1 = *(const h16x4*)(WAG + (m_ + 16) * 3072 + c4); pa1 = *(const h16x4*)(WAG + (m_ + 16) * 3072 + 1024 + c4); } while (0)
#define RW_DERIVE1(B_, tt_, r_, k_, v_, w_, a_) do { const f32x4 kf_ = f4(k_), af_ = f4(a_), wf_ = f4(w_); const f32x4 kk0_ = kf_ * kkw; \
            const float ss_ = reduce16((kk0_[0] * kk0_[0] + kk0_[1] * kk0_[1]) + (kk0_[2] * kk0_[2] + kk0_[3] * kk0_[3])); \
            const f32x4 kk_ = kk0_ * (1.0f / fmaxf(sqrtf(ss_), 1e-12f)); \
            f32x4 wd_; wd_[0] = fexp(wf_[0]); wd_[1] = fexp(wf_[1]); wd_[2] = fexp(wf_[2]); wd_[3] = fexp(wf_[3]); \
            *(f32x4*)(B_ + 0 * T * 64 + (tt_) * 64 + pc) = f4(r_); *(f32x4*)(B_ + 1 * T * 64 + (tt_) * 64 + pc) = wd_; \
            *(f32x4*)(B_ + 2 * T * 64 + (tt_) * 64 + pc) = kf_ * (1.0f + (af_ - 1.0f) * kaw); \
            *(f32x4*)(B_ + 3 * T * 64 + (tt_) * 64 + pc) = -kk_; *(f32x4*)(B_ + 4 * T * 64 + (tt_) * 64 + pc) = kk_ * af_; \
            if ((pc >> 5) == half) *(f32x4*)(B_ + 5 * T * 64 + (tt_) * 32 + (pc & 31)) = f4(v_); } while (0)
#define RW_DERIVE(buf) do { float* Bd_ = L + (buf) * BUF_FLOATS; RW_DERIVE1(Bd_, pt, pr0, pk0, pv0, pw0, pa0); RW_DERIVE1(Bd_, pt + 16, pr1, pk1, pv1, pw1, pa1); } while (0)
#define RW_YOUT(ch, ybuf) do { const float* Yq_ = YpB + (ybuf) * YP_FLOATS; _Pragma("unroll") for (int e_ = 0; e_ < 2; ++e_) { \
            const int tt_ = (t2 >> 4) + 16 * e_, r2_ = (t2 & 15) * 2; const float* yp_ = Yq_ + (tt_ * 32 + r2_) * 8; \
            const f32x4 s0_ = *(const f32x4*)(yp_) + *(const f32x4*)(yp_ + 4), s1_ = *(const f32x4*)(yp_ + 8) + *(const f32x4*)(yp_ + 12); \
            h16x2 o_; o_[0] = (h16)((s0_[0] + s0_[1]) + (s0_[2] + s0_[3])); o_[1] = (h16)((s1_[0] + s1_[1]) + (s1_[2] + s1_[3])); \
            *(h16x2*)(Y + ((size_t)b * SEQ + (ch) * T + tt_) * 1024 + hd * 64 + half * 32 + r2_) = o_; } } while (0)
#define RW_LOAD(X, arr, tt_) do { X##0 = *(const f32x4*)(B + (arr) * T * 64 + (tt_) * 64 + kq * 8); X##1 = *(const f32x4*)(B + (arr) * T * 64 + (tt_) * 64 + kq * 8 + 4); } while (0)
#define RW_DOT(a, b) (((a##0[0] * b##0[0] + a##0[1] * b##0[1]) + (a##0[2] * b##0[2] + a##0[3] * b##0[3])) + ((a##1[0] * b##1[0] + a##1[1] * b##1[1]) + (a##1[2] * b##1[2] + a##1[3] * b##1[3])))
        __syncthreads();
        if (wave >= 4) { RW_ISSUE(0); RW_DERIVE(0); RW_ISSUE(1); }
        __syncthreads();
        for (int ch = 0; ch < NC; ++ch) {
            const int buf = ch & 1;
            if (wave < 4) {
                const float* B = L + buf * BUF_FLOATS;
                float* Yp = YpB + buf * YP_FLOATS;
#define LO2(v) __builtin_shufflevector(v, v, 0, 1)
#define HI2(v) __builtin_shufflevector(v, v, 2, 3)
#define RW_LD4(a, b, c, d, arr, tt_) do { const f32x4 x0_ = *(const f32x4*)(B + (arr) * T * 64 + (tt_) * 64 + kq * 8), x1_ = *(const f32x4*)(B + (arr) * T * 64 + (tt_) * 64 + kq * 8 + 4); \
                    a = LO2(x0_); b = HI2(x0_); c = LO2(x1_); d = HI2(x1_); } while (0)
                f32x2 na0, na1, na2, na3, w0, w1, w2, w3, kv0, kv1, kv2, kv3, bb0, bb1, bb2, bb3, rv0, rv1, rv2, rv3; float vv;
                RW_LD4(na0, na1, na2, na3, 3, 0); RW_LD4(w0, w1, w2, w3, 1, 0); RW_LD4(kv0, kv1, kv2, kv3, 2, 0); RW_LD4(bb0, bb1, bb2, bb3, 4, 0); RW_LD4(rv0, rv1, rv2, rv3, 0, 0); vv = B[5 * T * 64 + rr];
                f32x2 Sa = LO2(S0), Sb = HI2(S0), Sc = LO2(S1), Sd = HI2(S1);
#pragma unroll 4
                for (int tt = 0; tt < T; ++tt) {
                    f32x2 xna0, xna1, xna2, xna3, xw0, xw1, xw2, xw3, xkv0, xkv1, xkv2, xkv3, xbb0, xbb1, xbb2, xbb3, xrv0, xrv1, xrv2, xrv3; float xvv;
                    const int tn = (tt + 1 < T) ? tt + 1 : tt;
                    RW_LD4(xna0, xna1, xna2, xna3, 3, tn); RW_LD4(xw0, xw1, xw2, xw3, 1, tn); RW_LD4(xkv0, xkv1, xkv2, xkv3, 2, tn); RW_LD4(xbb0, xbb1, xbb2, xbb3, 4, tn); RW_LD4(xrv0, xrv1, xrv2, xrv3, 0, tn);
                    xvv = B[5 * T * 64 + tn * 32 + rr];
                    f32x2 p = Sa * na0; p = Sb * na1 + p; p = Sc * na2 + p; p = Sd * na3 + p;
                    const float sa = reduce8(p[0] + p[1]);
                    Sa = Sa * w0 + (bb0 * sa + kv0 * vv); Sb = Sb * w1 + (bb1 * sa + kv1 * vv); Sc = Sc * w2 + (bb2 * sa + kv2 * vv); Sd = Sd * w3 + (bb3 * sa + kv3 * vv);
                    f32x2 q = Sa * rv0; q = Sb * rv1 + q; q = Sc * rv2 + q; q = Sd * rv3 + q;
                    Yp[(tt * 32 + rr) * 8 + kq] = q[0] + q[1];
                    na0 = xna0; na1 = xna1; na2 = xna2; na3 = xna3; w0 = xw0; w1 = xw1; w2 = xw2; w3 = xw3; kv0 = xkv0; kv1 = xkv1; kv2 = xkv2; kv3 = xkv3;
                    bb0 = xbb0; bb1 = xbb1; bb2 = xbb2; bb3 = xbb3; rv0 = xrv0; rv1 = xrv1; rv2 = xrv2; rv3 = xrv3; vv = xvv;
                }
                S0 = (f32x4){Sa[0], Sa[1], Sb[0], Sb[1]}; S1 = (f32x4){Sc[0], Sc[1], Sd[0], Sd[1]};
#undef LO2
#undef HI2
#undef RW_LD4
            } else {
                if (ch > 0) RW_YOUT(ch - 1, buf ^ 1);
                if (ch + 1 < NC) { RW_DERIVE(buf ^ 1); if (ch + 2 < NC) RW_ISSUE(ch + 2); }
            }
            LDS_BARRIER();
        }
        if (wave >= 4) RW_YOUT(NC - 1, (NC - 1) & 1);
        else {
            float* so = P.out + O_WKVP + ((size_t)(b * 16 + hd) * 64 + vrow) * 64 + kq * 8;
            *(f32x4*)so = S0; *(f32x4*)(so + 4) = S1;
        }
#undef RW_ISSUE
#undef RW_DERIVE1
#undef RW_DERIVE
#undef RW_YOUT
#undef RW_LOAD
#undef RW_DOT
    }
    {
        const int kq16 = lane & 15;
        const float* st_in = P.in(2); const float* kkp = P.in(22); const float* kap = P.in(23);
        for (int wt0 = c.gw; wt0 < NSB * 16 * 16; wt0 += 4 * c.NGW) {
            f32x4 r[4], k[4], wl[4], a[4], S[4]; float vv[4]; size_t so[4]; int c4v[4]; bool ok[4];
#pragma unroll
            for (int e = 0; e < 4; ++e) {
                const int wt = wt0 + e * c.NGW; ok[e] = wt < NSB * 16 * 16;
                const int wtc = ok[e] ? wt : wt0;
                const int pair = wtc >> 4, rg = wtc & 15, b = pair >> 4, hd = pair & 15;
                const int vrow = rg * 4 + (lane >> 4); c4v[e] = hd * 64 + kq16 * 4;
                const size_t m = (size_t)NPROMPT + b;
                r[e] = f4(*(const h16x4*)(RKV + m * 3072 + c4v[e])); k[e] = f4(*(const h16x4*)(RKV + m * 3072 + 1024 + c4v[e]));
                vv[e] = (float)RKV[m * 3072 + 2048 + hd * 64 + vrow];
                wl[e] = f4(*(const h16x4*)(WAG + m * 3072 + c4v[e])); a[e] = f4(*(const h16x4*)(WAG + m * 3072 + 1024 + c4v[e]));
                so[e] = ((size_t)(b * 16 + hd) * 64 + vrow) * 64 + kq16 * 4;
                S[e] = *(const f32x4*)(st_in + so[e]);
            }
#pragma unroll
            for (int e = 0; e < 4; ++e) {
                const f32x4 kk0 = k[e] * *(const f32x4*)(kkp + c4v[e]);
                const float ss = reduce16((kk0[0] * kk0[0] + kk0[1] * kk0[1]) + (kk0[2] * kk0[2] + kk0[3] * kk0[3]));
                const f32x4 kk = kk0 * (1.0f / fmaxf(sqrtf(ss), 1e-12f));
                const f32x4 kp = k[e] * (1.0f + (a[e] - 1.0f) * *(const f32x4*)(kap + c4v[e]));
                f32x4 wd; wd[0] = fexp(wl[e][0]); wd[1] = fexp(wl[e][1]); wd[2] = fexp(wl[e][2]); wd[3] = fexp(wl[e][3]);
                f32x4 Sx = S[e];
                const float sa = -reduce16((Sx[0] * kk[0] + Sx[1] * kk[1]) + (Sx[2] * kk[2] + Sx[3] * kk[3]));
                Sx = Sx * wd + ((kk * a[e]) * sa + kp * vv[e]);
                const float y = reduce16((Sx[0] * r[e][0] + Sx[1] * r[e][1]) + (Sx[2] * r[e][2] + Sx[3] * r[e][3]));
                if (ok[e]) {
                    __builtin_nontemporal_store(Sx, (f32x4*)(P.out + O_WKVS + so[e]));
                    if (kq16 == 0) Y[((size_t)NPROMPT + (so[e] >> 16)) * 1024 + ((so[e] >> 6) & 1023)] = (h16)y;
                }
            }
        }
    }
}

__device__ __forceinline__ void rwkv_post(const Ctx& c, const Params& P) {
    const h16* RKV = (const h16*)(P.ws + R_BIG + B_RKV); const h16* WAG = (const h16*)(P.ws + R_BIG + B_WAG); const h16* Y = (const h16*)(P.ws + R_BIG + B_Y);
    bf16_t* XN = (bf16_t*)(P.ws + R_XN);
    const float* pka = P.in(23); const float* prk = P.in(24); const float* plw = P.in(25); const float* plb = P.in(26);
    f32x4 ka[4], rkw[4], lw[4], lb[4];
#pragma unroll
    for (int j = 0; j < 4; ++j) { const int col = c.lane * 4 + 256 * j; ka[j] = *(const f32x4*)(pka + col); rkw[j] = *(const f32x4*)(prk + col); lw[j] = *(const f32x4*)(plw + col); lb[j] = *(const f32x4*)(plb + col); }
#define RP_LOAD(X, m_) do { _Pragma("unroll") for (int j_ = 0; j_ < 4; ++j_) { const int col_ = c.lane * 4 + 256 * j_; \
        X##y[j_] = *(const h16x4*)(Y + (size_t)(m_) * 1024 + col_); X##r[j_] = *(const h16x4*)(RKV + (size_t)(m_) * 3072 + col_); X##k[j_] = *(const h16x4*)(RKV + (size_t)(m_) * 3072 + 1024 + col_); \
        X##v[j_] = *(const h16x4*)(RKV + (size_t)(m_) * 3072 + 2048 + col_); X##a[j_] = *(const h16x4*)(WAG + (size_t)(m_) * 3072 + 1024 + col_); X##g[j_] = *(const h16x4*)(WAG + (size_t)(m_) * 3072 + 2048 + col_); } } while (0)
    h16x4 cy[4], cr[4], ck[4], cv[4], ca[4], cg[4], ny[4], nr[4], nk[4], nv[4], na[4], ng[4];
    int m = c.gw;
    if (m < MREAL) RP_LOAD(c, m);
    while (m < MREAL) {
        const int mn = m + c.NGW;
        if (mn < MREAL) RP_LOAD(n, mn);
#pragma unroll
        for (int j = 0; j < 4; ++j) {
            const int col = c.lane * 4 + 256 * j;
            const f32x4 y = f4(cy[j]), r = f4(cr[j]), k = f4(ck[j]), v = f4(cv[j]), a = f4(ca[j]), g = f4(cg[j]);
            const float mean = reduce16((y[0] + y[1]) + (y[2] + y[3])) * (1.0f / 64.0f);
            const f32x4 dy = y - mean;
            const float var = reduce16((dy[0] * dy[0] + dy[1] * dy[1]) + (dy[2] * dy[2] + dy[3] * dy[3])) * (1.0f / 64.0f);
            const float rs = 1.0f / sqrtf(var + 64e-5f);
            const f32x4 kp = k * (1.0f + (a - 1.0f) * ka[j]);
            const f32x4 rk = r * kp * rkw[j];
            const float bon = reduce16((rk[0] + rk[1]) + (rk[2] + rk[3]));
            const f32x4 yn = dy * rs * lw[j] + lb[j];
            *(u32x2*)(XN + (size_t)m * 1024 + col) = pk4((yn + v * bon) * g);
        }
#pragma unroll
        for (int j = 0; j < 4; ++j) { cy[j] = ny[j]; cr[j] = nr[j]; ck[j] = nk[j]; cv[j] = nv[j]; ca[j] = na[j]; cg[j] = ng[j]; }
        m = mn;
    }
#undef RP_LOAD
}

__device__ __forceinline__ float gk_to_e(float x) {
    return fexp(-softplusf_(-x) * (1.0f / 16.0f));
}
__device__ __forceinline__ bf16x8 lds_frag(const bf16_t* base, int row, int ld, int k0) { return *(const bf16x8*)(base + row * ld + k0); }
constexpr size_t B_GREC = B_O + (size_t)MP * 1024 * 4;
constexpr int GREC_HEAD = 45568, GREC_BYTES = 45568 + 36864;
__device__ __forceinline__ void gla_pre(const Ctx& c, const Params& P, unsigned char* ldsb) {
    const h16* Z = (const h16*)(P.ws + R_BIG + B_Z); const float* GL = (const float*)(P.ws + R_BIG + B_GL);
    unsigned char* GREC = P.ws + R_BIG + B_GREC;
    constexpr int CH = 64, NC = SEQ / CH, LDQ = 136, LDT = 72;
    bf16_t* QB  = (bf16_t*)(ldsb);
    bf16_t* KBT = (bf16_t*)(ldsb + 17408);
    bf16_t* ATT = (bf16_t*)(ldsb + 35840);
    float* EL = (float*)(ldsb + 45056);
    bf16_t* KB  = (bf16_t*)(ldsb + 45568);
    h16* QR = (h16*)(ldsb + 62976);
    h16* KR = (h16*)(ldsb + 79360);
    float* GLs = (float*)(ldsb + 95744);
    float* SEG = (float*)(ldsb + 99840);
    bf16_t* VT = (bf16_t*)(ldsb + 101888);
    const int tid = c.tid, lane = c.lane, wave = c.wave;
    const int fr = lane & 15, fq = lane >> 4;
    const int kx = tid & 127, tq = tid >> 7;
    const int lt = tid >> 3, lks = (tid & 7) * 16, vsx = tid & 63, vg = tid >> 6, gt = tid >> 2, g4 = (tid & 3) * 4;
    for (int task = blockIdx.x; task < 32 * NC; task += gridDim.x) {
        const int chain = task / NC, n = task % NC, b = chain >> 2, hd = chain & 3;
        const size_t m0 = (size_t)b * SEQ + n * CH;
        float wg[16];
#pragma unroll
        for (int i = 0; i < 16; ++i) wg[i] = P.in(29)[(size_t)i * 512 + hd * 128 + kx];
        const float bg = P.in(30)[hd * 128 + kx];
        __syncthreads();
        *(h16x8*)(QR + lt * 128 + lks) = *(const h16x8*)(Z + (m0 + lt) * 3072 + hd * 128 + lks); *(h16x8*)(QR + lt * 128 + lks + 8) = *(const h16x8*)(Z + (m0 + lt) * 3072 + hd * 128 + lks + 8);
        *(h16x8*)(KR + lt * 128 + lks) = *(const h16x8*)(Z + (m0 + lt) * 3072 + 512 + hd * 128 + lks); *(h16x8*)(KR + lt * 128 + lks + 8) = *(const h16x8*)(Z + (m0 + lt) * 3072 + 512 + hd * 128 + lks + 8);
        if (tid < 256) *(f32x4*)(GLs + gt * 16 + g4) = *(const f32x4*)(GL + (m0 + gt) * 16 + g4);
#pragma unroll
        for (int i = 0; i < 4; ++i) {
            const h16x8 pv = *(const h16x8*)(Z + (m0 + vsx) * 3072 + 1024 + hd * 256 + vg * 32 + 8 * i);
#pragma unroll
            for (int j = 0; j < 8; ++j) VT[(vg * 32 + 8 * i + j) * LDT + vsx] = (bf16_t)f2bf((float)pv[j]);
        }
        __syncthreads();
        float cb[16]; float run = 0.f;
#pragma unroll
        for (int i = 0; i < 16; ++i) {
            const float* g = GLs + (tq * 16 + i) * 16;
            const f32x4 g0 = *(const f32x4*)g, g1 = *(const f32x4*)(g + 4), g2 = *(const f32x4*)(g + 8), g3 = *(const f32x4*)(g + 12);
            float x = bg;
#pragma unroll
            for (int j = 0; j < 4; ++j) x += g0[j] * wg[j] + g1[j] * wg[4 + j] + g2[j] * wg[8 + j] + g3[j] * wg[12 + j];
            run += -softplusf_(-x) * (1.0f / 16.0f);
            cb[i] = run;
        }
        SEG[tq * 128 + kx] = run;
        __syncthreads();
        {
            const float s0 = SEG[kx], s1 = SEG[128 + kx], s2 = SEG[256 + kx], s3 = SEG[384 + kx];
            const float off = (tq > 0 ? s0 : 0.f) + (tq > 1 ? s1 : 0.f) + (tq > 2 ? s2 : 0.f);
            unsigned kt[8];
#pragma unroll
            for (int i = 0; i < 16; ++i) {
                const int t = tq * 16 + i;
                const float bb = fmaxf(off + cb[i], -80.f);
                const float eb = fexp(bb), enb = __builtin_amdgcn_rcpf(eb);
                const float qv = (float)QR[t * 128 + kx] * 0.08838834764831845f * eb, kv = (float)KR[t * 128 + kx] * enb;
                QB[t * LDQ + kx] = (bf16_t)f2bf(qv);
                const unsigned kb = f2bf(kv);
                KB[t * LDQ + kx] = (bf16_t)kb;
                if (i & 1) kt[i >> 1] |= kb << 16; else kt[i >> 1] = kb;
            }
            *(u32x4*)(KBT + kx * LDT + tq * 16) = (u32x4){kt[0], kt[1], kt[2], kt[3]};
            *(u32x4*)(KBT + kx * LDT + tq * 16 + 8) = (u32x4){kt[4], kt[5], kt[6], kt[7]};
            if (tq == 0) EL[kx] = fexp(fmaxf((s0 + s1) + (s2 + s3), -80.f));
        }
        __syncthreads();
        {
            const int si = wave & 3;
#pragma unroll
            for (int tj = 0; tj < 2; ++tj) {
                const int ti = 2 * (wave >> 2) + tj;
                f32x4 acc = (f32x4){0.f, 0.f, 0.f, 0.f};
                if (si <= ti) {
#pragma unroll
                    for (int kk = 0; kk < 4; ++kk)
                        acc = __builtin_amdgcn_mfma_f32_16x16x32_bf16(lds_frag(KB, si * 16 + fr, LDQ, kk * 32 + fq * 8), lds_frag(QB, ti * 16 + fr, LDQ, kk * 32 + fq * 8), acc, 0, 0, 0);
                }
                const int t = ti * 16 + fr, sb = si * 16 + fq * 4;
#pragma unroll
                for (int j = 0; j < 4; ++j) if (sb + j > t) acc[j] = 0.f;
                *(u32x2*)(ATT + t * LDT + sb) = pk4(acc);
            }
        }
        __syncthreads();
        {
            unsigned char* rec = GREC + (size_t)task * GREC_BYTES;
            for (int u = tid; u < GREC_HEAD / 16; u += 512) *(u32x4*)(rec + u * 16) = *(const u32x4*)(ldsb + u * 16);
            for (int u = tid; u < 36864 / 16; u += 512) *(u32x4*)(rec + GREC_HEAD + u * 16) = *(const u32x4*)((const unsigned char*)VT + u * 16);
        }
    }
}
__device__ __forceinline__ void gla_scan(const Ctx& c, const Params& P, unsigned char* ldsb) {
    const h16* Z = (const h16*)(P.ws + R_BIG + B_Z); const float* GL = (const float*)(P.ws + R_BIG + B_GL); float* O = (float*)(P.ws + R_BIG + B_O);
    const unsigned char* GREC = P.ws + R_BIG + B_GREC;
    constexpr int CH = 64, NC = SEQ / CH, LDQ = 136, LDT = 72;
    bf16_t* QB  = (bf16_t*)(ldsb);
    bf16_t* KBT = (bf16_t*)(ldsb + 17408);
    bf16_t* ATT = (bf16_t*)(ldsb + 35840);
    float* EL = (float*)(ldsb + 45056);
    bf16_t* VT = (bf16_t*)(ldsb + 45568);
    bf16_t* ST = (bf16_t*)(ldsb + 50176);
    float* L = (float*)ldsb;
    float* LE = L; float* LK = L + 128; float* LQ = L + 256; float* LOP = L + 384;
    const int tid = c.tid, lane = c.lane, wave = c.wave;
    const int fr = lane & 15, fq = lane >> 4;
    for (int task = blockIdx.x; task < 256; task += gridDim.x) {
        const int chain = task >> 3, vs = task & 7, b = chain >> 2, hd = chain & 3;
        __syncthreads();
        for (int i = tid; i < 2 * 32 * LDQ / 2; i += 512) ((unsigned*)ST)[i] = 0u;
        f32x4 Sacc[2]; Sacc[0] = (f32x4){0.f, 0.f, 0.f, 0.f}; Sacc[1] = Sacc[0];
        u32x4 preA[7], preB[7];
#define GL_ISSUE(X, n) do { const unsigned char* rec_ = GREC + (size_t)(chain * NC + (n)) * GREC_BYTES; \
            _Pragma("unroll") for (int i_ = 0; i_ < 6; ++i_) { const int u_ = tid + 512 * i_; if (u_ < GREC_HEAD / 16) pre##X[i_] = *(const u32x4*)(rec_ + u_ * 16); } \
            if (tid < 288) pre##X[6] = *(const u32x4*)(rec_ + GREC_HEAD + vs * 4608 + tid * 16); } while (0)
#define GL_FILL(X) do { _Pragma("unroll") for (int i_ = 0; i_ < 6; ++i_) { const int u_ = tid + 512 * i_; if (u_ < GREC_HEAD / 16) *(u32x4*)(ldsb + u_ * 16) = pre##X[i_]; } \
            if (tid < 288) *(u32x4*)((unsigned char*)VT + tid * 16) = pre##X[6]; } while (0)
        GL_ISSUE(A, 0); GL_ISSUE(B, 1);
        int cur = 0;
        for (int n = 0; n < NC; ++n) {
            const size_t m0 = (size_t)b * SEQ + n * CH;
            if (n & 1) GL_FILL(B); else GL_FILL(A);
            LDS_BARRIER();
            if (n + 2 < NC) { if (n & 1) GL_ISSUE(B, n + 2); else GL_ISSUE(A, n + 2); }
            {
                const int ti = wave >> 1, vi = wave & 1;
                const bf16_t* STc = ST + cur * 32 * LDQ;
                f32x4 acc = (f32x4){0.f, 0.f, 0.f, 0.f};
#pragma unroll
                for (int kk = 0; kk < 4; ++kk)
                    acc = __builtin_amdgcn_mfma_f32_16x16x32_bf16(lds_frag(STc, vi * 16 + fr, LDQ, kk * 32 + fq * 8), lds_frag(QB, ti * 16 + fr, LDQ, kk * 32 + fq * 8), acc, 0, 0, 0);
#pragma unroll
                for (int kk = 0; kk < 2; ++kk)
                    acc = __builtin_amdgcn_mfma_f32_16x16x32_bf16(lds_frag(VT, vi * 16 + fr, LDT, kk * 32 + fq * 8), lds_frag(ATT, ti * 16 + fr, LDT, kk * 32 + fq * 8), acc, 0, 0, 0);
                *(f32x4*)(O + (m0 + ti * 16 + fr) * 1024 + hd * 256 + vs * 32 + vi * 16 + fq * 4) = acc;
            }
            {
                bf16_t* STn = ST + (cur ^ 1) * 32 * LDQ;
                const f32x4 el = *(const f32x4*)(EL + wave * 16 + fq * 4);
#pragma unroll
                for (int vi = 0; vi < 2; ++vi) {
                    f32x4 acc = Sacc[vi];
#pragma unroll
                    for (int kk = 0; kk < 2; ++kk)
                        acc = __builtin_amdgcn_mfma_f32_16x16x32_bf16(lds_frag(KBT, wave * 16 + fr, LDT, kk * 32 + fq * 8), lds_frag(VT, vi * 16 + fr, LDT, kk * 32 + fq * 8), acc, 0, 0, 0);
                    acc = acc * el;
                    Sacc[vi] = acc;
                    *(u32x2*)(STn + (vi * 16 + fr) * LDQ + wave * 16 + fq * 4) = pk4(acc);
                }
            }
            LDS_BARRIER();
            cur ^= 1;
        }
#undef GL_FILL
#undef GL_ISSUE
#pragma unroll
        for (int vi = 0; vi < 2; ++vi)
#pragma unroll
            for (int j = 0; j < 4; ++j) P.out[O_GLAP + ((size_t)(b * 4 + hd) * 128 + wave * 16 + fq * 4 + j) * 256 + vs * 32 + vi * 16 + fr] = Sacc[vi][j];
    }
    {
        const float* st_in = P.in(4); const float* wgk = P.in(29); const float* bgk = P.in(30);
        for (int pair = blockIdx.x; pair < NSB * 4; pair += gridDim.x) {
            const int b = pair >> 2, hd = pair & 3;
            const size_t m = (size_t)NPROMPT + b;
            __syncthreads();
            if (tid < 128) {
                float x = bgk[hd * 128 + tid];
#pragma unroll
                for (int i = 0; i < 16; ++i) x += GL[m * 16 + i] * wgk[(size_t)i * 512 + hd * 128 + tid];
                LE[tid] = gk_to_e(x); LK[tid] = (float)Z[m * 3072 + 512 + hd * 128 + tid]; LQ[tid] = (float)Z[m * 3072 + hd * 128 + tid] * 0.08838834764831845f;
            }
            __syncthreads();
            const int v4 = (tid & 63) * 4, kg = tid >> 6;
            const f32x4 vval = f4(*(const h16x4*)(Z + m * 3072 + 1024 + hd * 256 + v4));
            f32x4 o = (f32x4){0.f, 0.f, 0.f, 0.f};
            const size_t sb = ((size_t)(b * 4 + hd) * 128 + kg * 16) * 256 + v4;
#pragma unroll
            for (int hb = 0; hb < 2; ++hb) {
                f32x4 s0[8];
#pragma unroll
                for (int j = 0; j < 8; ++j) s0[j] = *(const f32x4*)(st_in + sb + (size_t)(hb * 8 + j) * 256);
#pragma unroll
                for (int j = 0; j < 8; ++j) {
                    const int k = kg * 16 + hb * 8 + j;
                    const f32x4 sn = s0[j] * LE[k] + vval * LK[k];
                    o += sn * LQ[k];
                    __builtin_nontemporal_store(sn, (f32x4*)(P.out + O_GLAS + sb + (size_t)(hb * 8 + j) * 256));
                }
            }
            *(f32x4*)(LOP + kg * 256 + v4) = o;
            __syncthreads();
            if (tid < 256) { float r = 0.f;
#pragma unroll
                for (int g = 0; g < 8; ++g) r += LOP[g * 256 + tid];
                O[m * 1024 + hd * 256 + tid] = r; }
        }
    }
}
__device__ __forceinline__ void gla_post(const Ctx& c, const Params& P) {
    const h16* Z = (const h16*)(P.ws + R_BIG + B_Z); const float* O = (const float*)(P.ws + R_BIG + B_O); bf16_t* XN = (bf16_t*)(P.ws + R_XN);
    const f32x4 nw = *(const f32x4*)(P.in(31) + c.lane * 4);
#define GP_LOAD(X, m_) do { _Pragma("unroll") for (int j_ = 0; j_ < 4; ++j_) { const int col_ = c.lane * 4 + 256 * j_; \
        X##o[j_] = *(const f32x4*)(O + (size_t)(m_) * 1024 + col_); X##g[j_] = *(const h16x4*)(Z + (size_t)(m_) * 3072 + 2048 + col_); } } while (0)
    f32x4 co[4], no[4]; h16x4 cg[4], ng[4];
    int m = c.gw;
    if (m < MREAL) GP_LOAD(c, m);
    while (m < MREAL) {
        const int mn = m + c.NGW;
        if (mn < MREAL) GP_LOAD(n, mn);
#pragma unroll
        for (int j = 0; j < 4; ++j) {
            const int col = c.lane * 4 + 256 * j;
            const f32x4 o = co[j], g = f4(cg[j]);
            const float ms = wave_sum((o[0] * o[0] + o[1] * o[1]) + (o[2] * o[2] + o[3] * o[3])) * (1.0f / 256.0f);
            const float rs = 1.0f / sqrtf(ms + 1e-5f);
            f32x4 r;
#pragma unroll
            for (int i = 0; i < 4; ++i) r[i] = o[i] * rs * nw[i] * (g[i] * sigmoidf_(g[i]));
            *(u32x2*)(XN + (size_t)m * 1024 + col) = pk4(r);
        }
#pragma unroll
        for (int j = 0; j < 4; ++j) { co[j] = no[j]; cg[j] = ng[j]; }
        m = mn;
    }
#undef GP_LOAD
}

__device__ __forceinline__ f32x4 conv_zc(const h16* Z, size_t m, int col) { return f4(*(const h16x4*)(Z + m * 3072 + 1024 + col)) * f4(*(const h16x4*)(Z + m * 3072 + 2048 + col)); }
__device__ __forceinline__ void conv_mid(const Ctx& c, const Params& P) {
    const h16* Z = (const h16*)(P.ws + R_BIG + B_Z); bf16_t* XN = (bf16_t*)(P.ws + R_XN);
    const float* cw = P.in(34);
    for (int m = c.gw; m < MP; m += c.NGW) {
        if (m >= MREAL) continue;
#pragma unroll
        for (int j = 0; j < 4; ++j) {
            const int col = c.lane * 4 + 256 * j;
            const f32x4 z0 = conv_zc(Z, m, col);
            f32x4 z1 = (f32x4){0.f, 0.f, 0.f, 0.f}, z2 = z1;
            if (m < NPROMPT) {
                const int t = m & 2047, b = m >> 11;
                if (t >= 1) z1 = conv_zc(Z, m - 1, col);
                if (t >= 2) z2 = conv_zc(Z, m - 2, col);
                if (t >= 2046) *(f32x4*)(P.out + O_CONVP + ((size_t)b * 2 + (t - 2046)) * 1024 + col) = z0;
            } else {
                const int b = m - NPROMPT;
                z2 = *(const f32x4*)(P.in(5) + ((size_t)b * 2 + 0) * 1024 + col);
                z1 = *(const f32x4*)(P.in(5) + ((size_t)b * 2 + 1) * 1024 + col);
                *(f32x4*)(P.out + O_CONVS + ((size_t)b * 2 + 0) * 1024 + col) = z1;
                *(f32x4*)(P.out + O_CONVS + ((size_t)b * 2 + 1) * 1024 + col) = z0;
            }
            const f32x4 cv = *(const f32x4*)(cw + col) * z2 + *(const f32x4*)(cw + 1024 + col) * z1 + *(const f32x4*)(cw + 2048 + col) * z0;
            const f32x4 gB = f4(*(const h16x4*)(Z + (size_t)m * 3072 + col));
            *(u32x2*)(XN + (size_t)m * 1024 + col) = pk4(gB * cv);
        }
    }
}

__device__ __forceinline__ void pool_norm(const Ctx& c, const Params& P) {
    norm_rows<true>(c, P.out, P.in(7) + 3 * 1024, nullptr, (float*)(P.ws + R_BIG));
}
__device__ __forceinline__ void pool_mid(const Ctx& c, const Params& P) {
    const float* U = (const float*)(P.ws + R_BIG); bf16_t* XN = (bf16_t*)(P.ws + R_XN);
    const float* buf = P.in(6);
    for (int m = c.gw; m < MREAL; m += c.NGW) {
        f32x4 u[4], s[4]; float cnt[4];
        if (m < NPROMPT) {
            const int t = m & 2047;
#pragma unroll
            for (int j = 0; j < 4; ++j) {
                const int col = c.lane * 4 + 256 * j, w = 2 << j;
                u[j] = *(const f32x4*)(U + (size_t)m * 1024 + col);
                f32x4 a = u[j];
                if (t + 1 >= w) {
#pragma unroll
                    for (int i = 1; i < w; ++i) a += *(const f32x4*)(U + (size_t)(m - i) * 1024 + col);
                    cnt[j] = (float)w;
                } else {
                    for (int i = 1; i <= t; ++i) a += *(const f32x4*)(U + (size_t)(m - i) * 1024 + col);
                    cnt[j] = (float)(t + 1);
                }
                s[j] = a;
            }
        } else {
            const int b = m - NPROMPT;
#pragma unroll
            for (int j = 0; j < 4; ++j) {
                const int col = c.lane * 4 + 256 * j, w = 2 << j;
                u[j] = *(const f32x4*)(U + (size_t)m * 1024 + col);
                f32x4 a = u[j];
#pragma unroll
                for (int i = 1; i < w; ++i) a += *(const f32x4*)(buf + ((size_t)b * 15 + (15 - i)) * 1024 + col);
                cnt[j] = (float)w; s[j] = a;
            }
        }
#pragma unroll
        for (int j = 0; j < 4; ++j) {
            const int col = c.lane * 4 + 256 * j;
            *(u32x2*)(XN + (size_t)m * 1024 + col) = pk4(s[j] / cnt[j] - u[j]);
            if (m < NPROMPT) { const int t = m & 2047, b = m >> 11;
                if (t >= SEQ - 15) *(f32x4*)(P.out + O_POOLP + ((size_t)b * 15 + (t - (SEQ - 15))) * 1024 + col) = u[j]; }
        }
        if (m >= NPROMPT) {
            const int b = m - NPROMPT;
            for (int i = 0; i < 15; ++i)
#pragma unroll
                for (int j = 0; j < 4; ++j) {
                    const int col = c.lane * 4 + 256 * j;
                    const f32x4 val = (i < 14) ? *(const f32x4*)(buf + ((size_t)b * 15 + i + 1) * 1024 + col) : u[j];
                    *(f32x4*)(P.out + O_POOLS + ((size_t)b * 15 + i) * 1024 + col) = val;
                }
        }
    }
}

#define XB_TMO      128
#define XB_XCNT(j)  (256  + 64 * (j))
#define XB_XSUB(j)  (1280 + 64 * (j))
#define XB_XGEN(j)  (2304 + 64 * (j))
#define XB_TOP      3328
#define XB_TOPGEN   3392
#define XCD_BAR_WORDS 3456
#define XB_SPIN_CAP (1u << 18)
__device__ __forceinline__ unsigned xb_ld(unsigned* p)              { return __hip_atomic_load(p, __ATOMIC_RELAXED, __HIP_MEMORY_SCOPE_AGENT); }
__device__ __forceinline__ unsigned xb_add(unsigned* p, unsigned v) { return __hip_atomic_fetch_add(p, v, __ATOMIC_RELAXED, __HIP_MEMORY_SCOPE_AGENT); }
__device__ __forceinline__ unsigned xb_xcc_id() { return (unsigned)__builtin_amdgcn_s_getreg((3 << 11) | 20) & 0xFu; }
#define XB_SPIN(cond, bar) do { unsigned _sp = 0; while (cond) { __builtin_amdgcn_s_sleep(1); \
    if ((++_sp & 255u) == 0u) { if (xb_ld(&(bar)[XB_TMO])) break; if (_sp > XB_SPIN_CAP) { atomicAdd(&(bar)[XB_TMO], 1u); break; } } } } while (0)
struct XcdBarrier { unsigned* bar; unsigned x; volatile LAS unsigned* st; };
__device__ __forceinline__ void xcd_barrier_complete(unsigned* bar, unsigned x, unsigned& nloc, unsigned& nx) {
    const unsigned G = gridDim.x * gridDim.y * gridDim.z;
    unsigned sum, cnt, mine, sp = 0u;
    for (;;) {
        sum = 0u; cnt = 0u; mine = 0u;
#pragma unroll
        for (unsigned j = 0; j < 16; ++j) { const unsigned c = xb_ld(&bar[XB_XCNT(j)]); sum += c; cnt += (c > 0u) ? 1u : 0u; mine = (j == x) ? c : mine; }
        if (sum == G) break;
        __builtin_amdgcn_s_sleep(1);
        if ((++sp & 255u) == 0u) { if (xb_ld(&bar[XB_TMO])) break; if (sp > XB_SPIN_CAP) { atomicAdd(&bar[XB_TMO], 1u); break; } }
    }
    nloc = mine > 0u ? mine : 1u; nx = cnt > 0u ? cnt : 1u;
}
__device__ __forceinline__ void xcd_barrier(const XcdBarrier& b) {
    asm volatile("s_waitcnt vmcnt(0)" ::: "memory");
    __syncthreads();
    if (threadIdx.x == 0) {
        unsigned* bar = b.bar;
        __builtin_amdgcn_s_waitcnt(0);
        unsigned nloc = b.st[0], nx = b.st[1];
        if (nloc == 0u) { xcd_barrier_complete(bar, b.x, nloc, nx); b.st[0] = nloc; b.st[1] = nx; }
        const unsigned old = xb_add(&bar[XB_XSUB(b.x)], 1u);
        const unsigned gen = old / nloc;
        if (old + 1u == (gen + 1u) * nloc) {
            __builtin_amdgcn_fence(__ATOMIC_RELEASE, "agent");
            asm volatile("s_waitcnt vmcnt(0)" ::: "memory");
            const unsigned og = xb_add(&bar[XB_TOP], 1u);
            const unsigned tg = og / nx;
            if (og + 1u == (tg + 1u) * nx) xb_add(&bar[XB_TOPGEN], 1u);
            else XB_SPIN(xb_ld(&bar[XB_TOPGEN]) == tg, bar);
            __builtin_amdgcn_fence(__ATOMIC_ACQUIRE, "agent");
            xb_add(&bar[XB_XGEN(b.x)], 1u);
            asm volatile("s_waitcnt vmcnt(0)" ::: "memory");
        } else {
            XB_SPIN(xb_ld(&bar[XB_XGEN(b.x)]) == gen, bar);
            __builtin_amdgcn_fence(__ATOMIC_ACQUIRE, "agent");
            asm volatile("s_waitcnt vmcnt(0)" ::: "memory");
        }
    }
    __syncthreads();
}

__global__ void __launch_bounds__(512, 2) hybrid_fwd(Args A) {
    extern __shared__ __attribute__((aligned(16))) unsigned char lds[];
    cg::grid_group grid = cg::this_grid();
    Params P; P.tab = (LAS unsigned long long*)((LAS unsigned char*)lds + LDS_TAB); P.out = A.out; P.ws = A.ws;
    if (threadIdx.x == 0) {
#pragma unroll
        for (int i = 0; i < 38; ++i) P.tab[i] = (unsigned long long)A.in[i];
        P.tab[40] = 0ull;
    }
    if (blockIdx.x == 0) for (int i = threadIdx.x; i < XCD_BAR_WORDS; i += 512) ((unsigned*)(A.ws + WS_BAR))[i] = 0u;
    __syncthreads();

    Ctx c;
    const int wave0 = __builtin_amdgcn_readfirstlane(threadIdx.x >> 6);
#define FRESH() do { int w_ = wave0; unsigned ones_ = ~0u; asm volatile("" : "+s"(w_), "+s"(ones_)); \
        int l_ = (int)__builtin_amdgcn_mbcnt_hi(ones_, __builtin_amdgcn_mbcnt_lo(ones_, 0u)); asm volatile("" : "+v"(l_)); \
        int g_ = gridDim.x, b_ = blockIdx.x; asm volatile("" : "+s"(g_), "+s"(b_)); G = g_; cid = b_; \
        c.lane = l_; c.wave = w_; c.tid = w_ * 64 + l_; c.gw = b_ * 8 + w_; c.NGW = g_ * 8; \
        unsigned long long o_ = (unsigned long long)A.out, s_ = (unsigned long long)A.ws; asm volatile("" : "+s"(o_), "+s"(s_)); \
        P.out = (float*)(__attribute__((address_space(1))) float*)o_; P.ws = (unsigned char*)(__attribute__((address_space(1))) unsigned char*)s_; \
        h = P.out; XN = (bf16_t*)(P.ws + R_XN); } while (0)
#define SYNC0() do { grid.sync(); FRESH(); if (c.tid == 0) (void)xb_add((unsigned*)(P.ws + WS_BAR) + XB_XCNT(xb_xcc_id()), 1u); } while (0)
#define SYNC() do { XcdBarrier xb; xb.bar = (unsigned*)(P.ws + WS_BAR); xb.x = xb_xcc_id(); xb.st = (volatile LAS unsigned*)(P.tab + 40); xcd_barrier(xb); FRESH(); } while (0)
    LAS unsigned char* ldsl = (LAS unsigned char*)lds;
    LAS float* scr = (LAS float*)(ldsl + wave0 * 8448);
    int G, cid;
    float* h; bf16_t* XN;
    constexpr int NOGRP = 31;
    FRESH();

    for (int l = 0; l < 4; ++l) {
        if (l == 0) {
            rwkv_wprep(c, scr, P);
            rwkv_prep(c, P);
            SYNC0();
            { pg8::Gemm g{(const bf16_t*)(P.ws + R_BIG + B_U2), (const bf16_t*)(P.ws + R_W + W_MIX1), 2048, 2048, 2048, NOGRP, 0u};
              pg8::StaticOrder S; S.init(NPROMPT / 256, 15, G, cid);
              pg8::Epi<pg8::EP_RKV> E{(void*)(P.ws + R_BIG + B_RKV), (void*)(P.ws + R_BIG + B_LH), nullptr, nullptr};
              pg8::gemm_phase(c.tid, ldsl, g, S, E); FRESH(); pg8::thin_gemm<pg8::EP_RKV, false>(c.lane, c.wave, g, 3840, 1, E, lds); }
            SYNC();
            { pg8::Gemm g{(const bf16_t*)(P.ws + R_BIG + B_LH), (const bf16_t*)(P.ws + R_W + W_MIX2), 768, 256, 256, 2, 512u};
              pg8::StaticOrder S; S.init(NPROMPT / 256, 12, G, cid);
              pg8::Epi<pg8::EP_LORA2> E{(void*)(P.ws + R_BIG + B_WAG), nullptr, P.in(14), P.in(17)};
              pg8::gemm_phase(c.tid, ldsl, g, S, E); FRESH(); pg8::thin_gemm<pg8::EP_LORA2, false>(c.lane, c.wave, g, 3072, 1, E, lds); }
            SYNC();
            rwkv_scan(c, P, lds);
            SYNC();
            rwkv_post(c, P);
            SYNC();
        } else if (l == 1 || l == 2) {
            int base = 0;
            if (l == 1) {
                wprep(c, scr, base, P.in(28), 1024, 3088, 3088, (bf16_t*)(P.ws + R_W + W_MIX1), 1024, 3328, 1024, 0, 0, nullptr, 0);
                wprep(c, scr, base, P.in(32), 1024, 1024, 1024, (bf16_t*)(P.ws + R_W + W_WO), 1024, 1024, 1024, 0, 0, nullptr, 0);
            } else {
                wprep(c, scr, base, P.in(33), 1024, 3072, 3072, (bf16_t*)(P.ws + R_W + W_MIX1), 1024, 3072, 1024, 0, 0, nullptr, 0);
                wprep(c, scr, base, P.in(35), 1024, 1024, 1024, (bf16_t*)(P.ws + R_W + W_WO), 1024, 1024, 1024, 0, 0, nullptr, 0);
            }
            wprep_ffn(c, scr, base, P, l);
            norm_to_xn(c, h, P.in(7) + l * 1024, XN);
            SYNC();
            { pg8::Gemm g{XN, (const bf16_t*)(P.ws + R_W + W_MIX1), 1024, 1024, 1024, NOGRP, 0u};
              pg8::StaticOrder S; S.init(NPROMPT / 256, 12, G, cid);
              if (l == 1) pg8::gl_direct(c.lane, c.gw, c.NGW, XN, g.Bt, (float*)(P.ws + R_BIG + B_GL));
              pg8::Epi<pg8::EP_Z> E{(void*)(P.ws + R_BIG + B_Z), (void*)(P.ws + R_BIG + B_GL), nullptr, nullptr};
              pg8::gemm_phase(c.tid, ldsl, g, S, E); FRESH(); pg8::thin_gemm<pg8::EP_Z, false>(c.lane, c.wave, g, l == 1 ? 3328 : 3072, 1, E, lds); }
            SYNC();
            if (l == 1) { gla_pre(c, P, lds); SYNC(); gla_scan(c, P, lds); SYNC(); gla_post(c, P); }
            else conv_mid(c, P);
            SYNC();
        } else {
            int base = 0;
            for (int gi = 0; gi < 4; ++gi)
                wprep(c, scr, base, P.in(36) + gi * 65536, 256, 256, 256, (bf16_t*)(P.ws + R_W + W_MIX1), 256, 256, 256, gi * 256, 0, P.in(37) + gi * 256, 3);
            wprep_ffn(c, scr, base, P, 3);
            pool_norm(c, P);
            SYNC();
            pool_mid(c, P);
            SYNC();
        }
        { pg8::Gemm g = (l == 3) ? pg8::Gemm{XN, (const bf16_t*)(P.ws + R_W + W_MIX1), 1024, 256, 256, 0, 512u}
                                 : pg8::Gemm{XN, (const bf16_t*)(P.ws + R_W + W_WO), 1024, 1024, 1024, NOGRP, 0u};
          pg8::StaticOrder S; S.init(NPROMPT / 256, 4, G, cid);
          pg8::Epi<pg8::EP_RESI> E{(void*)h, nullptr, (l == 0) ? P.in(0) : nullptr, nullptr};
          pg8::gemm_phase(c.tid, ldsl, g, S, E); FRESH(); pg8::thin_gemm<pg8::EP_RESI, true>(c.lane, c.wave, g, 1024, (l == 3) ? 1 : 4, E, lds); }
        SYNC();
        norm_to_xn(c, h, P.in(8) + l * 1024, XN);
        SYNC();
        { pg8::Gemm g{XN, (const bf16_t*)(P.ws + R_W + W_UP), 1024, 1024, 1024, NOGRP, 0u};
          pg8::StaticOrder S; S.init(NPROMPT / 256, 16, G, cid);
          pg8::Epi<pg8::EP_UP> E{(void*)(P.ws + R_BIG), nullptr, nullptr, nullptr};
          pg8::gemm_phase(c.tid, ldsl, g, S, E); FRESH(); pg8::thin_gemm<pg8::EP_UP, false>(c.lane, c.wave, g, 4096, 1, E, lds); }
        SYNC();
        { pg8::Gemm g{(const bf16_t*)(P.ws + R_BIG), (const bf16_t*)(P.ws + R_W + W_DOWN), 4096, 4096, 4096, NOGRP, 0u};
          pg8::StaticOrder S; S.init(NPROMPT / 256, 4, G, cid);
          pg8::Epi<pg8::EP_RESI> E{(void*)h, nullptr, nullptr, nullptr};
          pg8::gemm_phase(c.tid, ldsl, g, S, E); FRESH(); pg8::thin_gemm<pg8::EP_RESI, true>(c.lane, c.wave, g, 1024, 4, E, lds); }
        SYNC();
    }
    norm_rows<true, true>(c, h, P.in(9), nullptr, h);
}

extern "C" void kernel_launch(void* const* d_in, const int* in_sizes, int n_in, void* d_out, int out_size, void* d_ws, size_t ws_size, hipStream_t stream) {
    static int grid = 0;
    if (grid == 0) {
        if (n_in != 38 || ws_size < WS_NEED) { fprintf(stderr, "kernel_launch: need 38 inputs and %zu bytes of workspace; got %d, %zu\n", (size_t)WS_NEED, n_in, ws_size); grid = -1; return; }
        int dev = 0, cus = 0, per_cu = 0;
        (void)hipGetDevice(&dev);
        (void)hipDeviceGetAttribute(&cus, hipDeviceAttributeMultiprocessorCount, dev);
        if (hipFuncSetAttribute((const void*)hybrid_fwd, hipFuncAttributeMaxDynamicSharedMemorySize, LDS_BYTES) != hipSuccess) { fprintf(stderr, "kernel_launch: hipFuncSetAttribute failed\n"); grid = -1; return; }
        if (hipOccupancyMaxActiveBlocksPerMultiprocessor(&per_cu, (const void*)hybrid_fwd, 512, LDS_BYTES) != hipSuccess || per_cu < 1) { fprintf(stderr, "kernel_launch: occupancy query failed (%d)\n", per_cu); grid = -1; return; }
        grid = cus;
    }
    if (grid < 0) return;
    Args p{};
    for (int i = 0; i < 38; ++i) p.in[i] = (const float*)d_in[i];
    p.out = (float*)d_out; p.ws = (unsigned char*)d_ws;
    void* args[] = {&p};
    hipError_t e = hipLaunchCooperativeKernel((const void*)hybrid_fwd, dim3(grid), dim3(512), args, LDS_BYTES, stream);
    if (e != hipSuccess) fprintf(stderr, "cooperative launch failed: %s (grid %d)\n", hipGetErrorString(e), grid);
}
```
